# Optimizing an MI355X kernel written in HIP

```python
import jax, jax.numpy as jnp
from jax import lax
import numpy as np

D_MODEL = 2048
BATCH = 32
SEQ = 256
DEPTH = 2
DEC_BATCH = 8
DEC_SEQ = 1024
PAST_LEN = 256

GRID_W = 64
RET_HEADS = 8
RET_DK = 128
RET_DV = 256
CHUNK = 128
GM_GROUPS = 4
GM_WIDTH = 1024
GM_GROUP_DIM = GM_WIDTH // GM_GROUPS
NA_HEADS = 8
NA_HEAD_DIM = 128
NA_WIN_ROWS = 8
NA_WIN_COLS = 16
FFN_DIM = 5632
N_SUB = 3
ROPE_BASE = 10000.0
NORM_EPS = 1e-6
Q_BLOCK = 128
NEG_INF = -1e30
RET_QK_W = RET_HEADS * RET_DK
RET_W = RET_HEADS * RET_DV
NA_W = NA_HEADS * NA_HEAD_DIM
IN_SIZES = (RET_QK_W, RET_QK_W, RET_W, RET_W, GM_WIDTH, GM_WIDTH, NA_W, NA_W, NA_W, D_MODEL, D_MODEL, D_MODEL)
IN_WIDTH = 2 * RET_QK_W + 2 * RET_W + 2 * GM_WIDTH + 3 * NA_W + 3 * D_MODEL

kernel_name = "hybrid_dit_retention_gmlp_natten_step"


def rms_norm(x, w):
    xf = x.astype(jnp.float32)
    y = xf * lax.rsqrt(jnp.mean(xf * xf, axis=-1, keepdims=True) + NORM_EPS)
    return (y * w).astype(x.dtype)


def layer_norm(x, w):
    xf = x.astype(jnp.float32)
    mu = jnp.mean(xf, axis=-1, keepdims=True)
    var = jnp.mean(jnp.square(xf - mu), axis=-1, keepdims=True)
    return ((xf - mu) * lax.rsqrt(var + NORM_EPS) * w).astype(x.dtype)


def mod_part(mod, i, j):
    s = (3 * i + j) * D_MODEL
    return mod[..., s:s + D_MODEL]


def modulated_input(x, mod, i, g_pre):
    return rms_norm(x, g_pre) * (1.0 + mod_part(mod, i, 1)) + mod_part(mod, i, 0)


def gated_residual(x, mod, i, out, g_post, res_w):
    return x + res_w * mod_part(mod, i, 2) * rms_norm(out, g_post)


def swiglu(h, w_in, w_out):
    a, b = jnp.split(h @ w_in, 2, axis=-1)
    return (jax.nn.silu(a) * b) @ w_out


def ffn_sublayer(x, mod, i, g_pre, g_post, w_in, w_out):
    h = modulated_input(x, mod, i, g_pre)
    return gated_residual(x, mod, i, swiglu(h, w_in, w_out), g_post, 0.5)


def split_projection(z):
    out, start = [], 0
    for size in IN_SIZES:
        out.append(z[..., start:start + size])
        start += size
    return out


def to_heads(x, n_heads):
    return x.reshape(x.shape[0], x.shape[1], n_heads, -1)


def axial_rotary(x):
    L, d = x.shape[1], x.shape[-1]
    t = jnp.arange(L)
    pos_r = (t // GRID_W).astype(jnp.float32)
    pos_c = (t % GRID_W).astype(jnp.float32)
    half = d // 2
    inv = ROPE_BASE ** (-jnp.arange(0, half, 2, dtype=jnp.float32) / half)

    def rotate(xa, pos):
        ang = pos[:, None] * inv[None, :]
        cos = jnp.cos(ang)[None, :, None, :]
        sin = jnp.sin(ang)[None, :, None, :]
        x1, x2 = xa[..., :half // 2], xa[..., half // 2:]
        return jnp.concatenate([x1 * cos - x2 * sin, x1 * sin + x2 * cos], axis=-1)

    return jnp.concatenate([rotate(x[..., :half], pos_r), rotate(x[..., half:], pos_c)], axis=-1).astype(x.dtype)


def retention_dir(q, k, v, log_g, s0):
    Bn, L, H, dk = q.shape
    dv = v.shape[-1]
    n = L // CHUNK
    qc = q.reshape(Bn, n, CHUNK, H, dk)
    kc = k.reshape(Bn, n, CHUNK, H, dk)
    vc = v.reshape(Bn, n, CHUNK, H, dv)
    pos = jnp.arange(CHUNK, dtype=jnp.float32)
    diff = pos[:, None] - pos[None, :]
    dmask = jnp.where(diff >= 0, jnp.exp(log_g[:, None, None] * jnp.maximum(diff, 0.0)), 0.0)
    scores = jnp.einsum('bnihd,bnjhd->bnhij', qc, kc) * dmask[None, None]
    inner = jnp.einsum('bnhij,bnjhe->bnihe', scores, vc)
    zeta = jnp.exp(log_g[:, None] * (CHUNK - 1.0 - pos)[None, :])
    kv = jnp.einsum('bnjhd,hj,bnjhe->bnhde', kc, zeta, vc)
    g_chunk = jnp.exp(log_g * CHUNK)[None, :, None, None]

    def step(s, kv_i):
        return g_chunk * s + kv_i, s

    s_final, s_prev = lax.scan(step, s0.astype(kv.dtype), jnp.moveaxis(kv, 1, 0))
    s_prev = jnp.moveaxis(s_prev, 0, 1)
    xi = jnp.exp(log_g[:, None] * (pos + 1.0)[None, :])
    cross = jnp.einsum('bnihd,bnhde->bnihe', qc, s_prev) * xi.T[None, None, :, :, None]
    return (inner + cross).reshape(Bn, L, H, dv), s_final


def retention_branch(q, k, v, g, log_g, s0_f, s0_b):
    Bn, L = q.shape[0], q.shape[1]
    k = k * (RET_DK ** -0.5)
    o_f, s_f = retention_dir(q, k, v, log_g[0], s0_f)
    o_b, s_b = retention_dir(jnp.flip(q, 1), jnp.flip(k, 1), jnp.flip(v, 1), log_g[1], s0_b)
    o = (o_f + jnp.flip(o_b, 1)).astype(jnp.float32)
    o = o * lax.rsqrt(jnp.mean(o * o, axis=-1, keepdims=True) + NORM_EPS)
    o = o.astype(q.dtype) * jax.nn.silu(g.reshape(Bn, L, RET_HEADS, RET_DV))
    return o.reshape(Bn, L, RET_W), s_f, s_b


def spatial_gating(u, v, gm_norm, gm_ws, gm_bs):
    Bn, L, _ = u.shape
    n = L // CHUNK
    vn = layer_norm(v, gm_norm).reshape(Bn, n, CHUNK, GM_GROUPS, GM_GROUP_DIM)
    mixed = jnp.einsum('gij,bnjgc->bnigc', gm_ws, vn) + gm_bs.T[None, None, :, :, None]
    return u * mixed.reshape(Bn, L, GM_WIDTH)


def dense_attention(q, k, v):
    Bn, Lq, H, d = q.shape
    scale = d ** -0.5
    qb = jnp.moveaxis(q.reshape(Bn, Lq // Q_BLOCK, Q_BLOCK, H, d), 1, 0)

    def one_block(qblk):
        s = jnp.einsum('bqhd,bkhd->bhqk', qblk, k).astype(jnp.float32) * scale
        p = jax.nn.softmax(s, axis=-1).astype(v.dtype)
        return jnp.einsum('bhqk,bkhd->bqhd', p, v)

    o = lax.map(one_block, qb)
    return jnp.moveaxis(o, 0, 1).reshape(Bn, Lq, H * d)


def neighbourhood_attention(q, k, v, k_ctx, v_ctx, rpb):
    Bn, L, H, d = q.shape
    rows = L // GRID_W
    wr = min(NA_WIN_ROWS, rows)
    scale = d ** -0.5
    r = jnp.arange(rows)
    row_start = jnp.clip(r - wr // 2, 0, rows - wr)
    row_idx = row_start[:, None] + jnp.arange(wr)[None, :]
    qg = q.reshape(Bn, rows, GRID_W, H, d)
    kb = jnp.take(k.reshape(Bn, rows, GRID_W, H, d), row_idx, axis=1)
    vb = jnp.take(v.reshape(Bn, rows, GRID_W, H, d), row_idx, axis=1)
    s_loc = jnp.einsum('brqhd,brjkhd->brhqjk', qg, kb).astype(jnp.float32) * scale
    cidx = jnp.arange(GRID_W)
    col_start = jnp.clip(cidx - NA_WIN_COLS // 2, 0, GRID_W - NA_WIN_COLS)
    col_valid = (cidx[None, :] >= col_start[:, None]) & (cidx[None, :] < col_start[:, None] + NA_WIN_COLS)
    col_i = jnp.clip(cidx[None, :] - cidx[:, None] + NA_WIN_COLS - 1, 0, 2 * NA_WIN_COLS - 2)
    row_off = row_idx - r[:, None] + NA_WIN_ROWS - 1
    bias = rpb[:, row_off][..., col_i]
    bias = jnp.transpose(bias, (1, 0, 3, 2, 4)).astype(jnp.float32)
    s_loc = jnp.where(col_valid[:, None, :], s_loc + bias[None], NEG_INF)
    s_ctx = jnp.einsum('brqhd,bkhd->brhqk', qg, k_ctx).astype(jnp.float32) * scale
    n_loc = wr * GRID_W
    s_all = jnp.concatenate([s_loc.reshape(Bn, rows, H, GRID_W, n_loc), s_ctx], axis=-1)
    p = jax.nn.softmax(s_all, axis=-1).astype(v.dtype)
    p_loc = p[..., :n_loc].reshape(Bn, rows, H, GRID_W, wr, GRID_W)
    p_ctx = p[..., n_loc:]
    o = jnp.einsum('brhqjk,brjkhd->brqhd', p_loc, vb) + jnp.einsum('brhqk,bkhd->brqhd', p_ctx, v_ctx)
    return o.reshape(Bn, L, H * d)


def merge_branches(ret, gm, na, g_a, g_b, g_c, w_br, w_bg, w_bn, w_out):
    m = jax.nn.sigmoid(g_a) * (ret @ w_br) + jax.nn.sigmoid(g_b) * (gm @ w_bg) + jax.nn.sigmoid(g_c) * (na @ w_bn)
    return m @ w_out


def mix_context(h, w_in, ret_logit, gm_norm, gm_ws, gm_bs, w_br, w_bg, w_bn, w_out):
    Bn = h.shape[0]
    qa, ka, va, ga, ub, vb, qc, kc, vc, g_a, g_b, g_c = split_projection(h @ w_in)
    log_g = jax.nn.log_sigmoid(ret_logit.astype(jnp.float32))
    s0 = jnp.zeros((Bn, RET_HEADS, RET_DK, RET_DV), jnp.float32)
    ret, s_f, s_b = retention_branch(to_heads(qa, RET_HEADS), to_heads(ka, RET_HEADS), to_heads(va, RET_HEADS), ga, log_g, s0, s0)
    gm = spatial_gating(ub, vb, gm_norm, gm_ws, gm_bs)
    k_c = to_heads(kc, NA_HEADS)
    v_c = to_heads(vc, NA_HEADS)
    na = dense_attention(to_heads(qc, NA_HEADS), k_c, v_c)
    y = merge_branches(ret, gm, na, g_a, g_b, g_c, w_br, w_bg, w_bn, w_out)
    return y, k_c, v_c, jnp.stack([s_f, s_b], axis=1)


def mix_latent(h, ctx_k, ctx_v, ret_state, w_in, ret_logit, gm_norm, gm_ws, gm_bs, rpb, w_br, w_bg, w_bn, w_out):
    qa, ka, va, ga, ub, vb, qc, kc, vc, g_a, g_b, g_c = split_projection(h @ w_in)
    log_g = jax.nn.log_sigmoid(ret_logit.astype(jnp.float32))
    ret, _, _ = retention_branch(axial_rotary(to_heads(qa, RET_HEADS)), axial_rotary(to_heads(ka, RET_HEADS)),
                                 to_heads(va, RET_HEADS), ga, log_g, ret_state[:, 0], ret_state[:, 1])
    gm = spatial_gating(ub, vb, gm_norm, gm_ws, gm_bs)
    na = neighbourhood_attention(to_heads(qc, NA_HEADS), to_heads(kc, NA_HEADS), to_heads(vc, NA_HEADS), ctx_k, ctx_v, rpb)
    return merge_branches(ret, gm, na, g_a, g_b, g_c, w_br, w_bg, w_bn, w_out)


def setup_inputs(seed: int = 0) -> dict:
    key = jax.random.key(seed)
    ks = jax.random.split(key, 24)
    D = D_MODEL

    def nrm(k, shape, s):
        return jax.random.normal(k, shape, jnp.float32) * s

    gamma0 = 1.0 - 2.0 ** (-5.0 - jnp.arange(RET_HEADS, dtype=jnp.float32))
    logit0 = jnp.log(gamma0) - jnp.log1p(-gamma0)
    return {
        "x_prompt": nrm(ks[0], (BATCH, SEQ, D), 1.0),
        "x_sample": nrm(ks[1], (DEC_BATCH, DEC_SEQ, D), 1.0),
        "cache_k": nrm(ks[2], (DEC_BATCH, DEPTH, PAST_LEN, NA_HEADS, NA_HEAD_DIM), 1.0),
        "cache_v": nrm(ks[3], (DEC_BATCH, DEPTH, PAST_LEN, NA_HEADS, NA_HEAD_DIM), 1.0),
        "state_ret": nrm(ks[4], (DEC_BATCH, DEPTH, 2, RET_HEADS, RET_DK, RET_DV), 1.0),
        "c": nrm(ks[5], (DEC_BATCH, D), 1.0),
        "c_ctx": nrm(ks[6], (D,), 1.0),
        "w_ada": nrm(ks[7], (DEPTH, D, 3 * N_SUB * D), 0.5 * D ** -0.5),
        "b_ada": nrm(ks[8], (DEPTH, 3 * N_SUB * D), 0.02),
        "norm_pre": 1.0 + nrm(ks[9], (DEPTH, N_SUB, D), 0.05),
        "norm_post": 1.0 + nrm(ks[10], (DEPTH, N_SUB, D), 0.05),
        "ffn_w_in": nrm(ks[11], (DEPTH, 2, D, 2 * FFN_DIM), D ** -0.5),
        "ffn_w_out": nrm(ks[12], (DEPTH, 2, FFN_DIM, D), FFN_DIM ** -0.5),
        "w_in": nrm(ks[13], (DEPTH, D, IN_WIDTH), D ** -0.5),
        "ret_decay_logit": logit0[None, None, :] + nrm(ks[14], (DEPTH, 2, RET_HEADS), 0.1),
        "gm_norm": 1.0 + nrm(ks[15], (DEPTH, GM_WIDTH), 0.05),
        "gm_ws": nrm(ks[16], (DEPTH, GM_GROUPS, CHUNK, CHUNK), CHUNK ** -0.5),
        "gm_bs": nrm(ks[17], (DEPTH, GM_GROUPS, CHUNK), 0.02),
        "na_rpb": nrm(ks[18], (DEPTH, NA_HEADS, 2 * NA_WIN_ROWS - 1, 2 * NA_WIN_COLS - 1), 0.1),
        "w_branch_ret": nrm(ks[19], (DEPTH, RET_W, D), RET_W ** -0.5),
        "w_branch_gm": nrm(ks[20], (DEPTH, GM_WIDTH, D), GM_WIDTH ** -0.5),
        "w_branch_na": nrm(ks[21], (DEPTH, NA_W, D), NA_W ** -0.5),
        "w_out": nrm(ks[22], (DEPTH, D, D), D ** -0.5),
    }


def reference(x_prompt, x_sample, cache_k, cache_v, state_ret, c, c_ctx,
              w_ada, b_ada, norm_pre, norm_post, ffn_w_in, ffn_w_out, w_in,
              ret_decay_logit, gm_norm, gm_ws, gm_bs, na_rpb,
              w_branch_ret, w_branch_gm, w_branch_na, w_out):
    x = x_prompt
    ks_out, vs_out, ss_out = [], [], []
    for l in range(DEPTH):
        mod = (jax.nn.silu(c_ctx) @ w_ada[l] + b_ada[l])[None, None, :]
        x = ffn_sublayer(x, mod, 0, norm_pre[l, 0], norm_post[l, 0], ffn_w_in[l, 0], ffn_w_out[l, 0])
        h = modulated_input(x, mod, 1, norm_pre[l, 1])
        y, k_c, v_c, s_c = mix_context(h, w_in[l], ret_decay_logit[l], gm_norm[l], gm_ws[l], gm_bs[l],
                                       w_branch_ret[l], w_branch_gm[l], w_branch_na[l], w_out[l])
        x = gated_residual(x, mod, 1, y, norm_post[l, 1], 1.0)
        x = ffn_sublayer(x, mod, 2, norm_pre[l, 2], norm_post[l, 2], ffn_w_in[l, 1], ffn_w_out[l, 1])
        ks_out.append(k_c)
        vs_out.append(v_c)
        ss_out.append(s_c)
    y_prompt = x
    new_cache_k = jnp.stack(ks_out, axis=1)
    new_cache_v = jnp.stack(vs_out, axis=1)
    new_state_ret = jnp.stack(ss_out, axis=1)

    x = x_sample
    for l in range(DEPTH):
        mod = (jax.nn.silu(c) @ w_ada[l] + b_ada[l])[:, None, :]
        x = ffn_sublayer(x, mod, 0, norm_pre[l, 0], norm_post[l, 0], ffn_w_in[l, 0], ffn_w_out[l, 0])
        h = modulated_input(x, mod, 1, norm_pre[l, 1])
        y = mix_latent(h, cache_k[:, l], cache_v[:, l], state_ret[:, l], w_in[l], ret_decay_logit[l],
                       gm_norm[l], gm_ws[l], gm_bs[l], na_rpb[l],
                       w_branch_ret[l], w_branch_gm[l], w_branch_na[l], w_out[l])
        x = gated_residual(x, mod, 1, y, norm_post[l, 1], 1.0)
        x = ffn_sublayer(x, mod, 2, norm_pre[l, 2], norm_post[l, 2], ffn_w_in[l, 1], ffn_w_out[l, 1])
    y_sample = x
    return (y_prompt, y_sample, new_cache_k, new_cache_v, new_state_ret)
```

```cpp
#include <hip/hip_runtime.h>
#include <cstdio>
#include <cstdint>
namespace pg8 {
#define PG8_LAS __attribute__((address_space(3)))
typedef unsigned short bf16_t;
typedef short bf16x8 __attribute__((ext_vector_type(8)));
typedef float f32x4 __attribute__((ext_vector_type(4)));
typedef unsigned u32x4 __attribute__((ext_vector_type(4)));
constexpr int BM = 256, BK = 64, HALF = 128, HTB = HALF * BK * 2  , STAGE_BYTES = 8 * HTB, NXCD = 8, WGM = 8;

__host__ __device__ __forceinline__ int lds_byte(int r, int c) { const int st = (r >> 4) * 2 + (c >> 5), rr = r & 15, cc = c & 31, ob = rr * 64 + cc * 2; return st * 1024 + (ob ^ (((ob >> 9) & 1) << 5)); }
__host__ __device__ __forceinline__ void stage_rc(int b, int& R, int& C) { const int st = b / 1024, sb = b % 1024, swz = sb ^ (((sb >> 9) & 1) << 5); R = (st >> 1) * 16 + swz / 64; C = (st & 1) * 32 + (swz % 64) / 2; }
__host__ __device__ __forceinline__ int perm32(int rho) { const int n = rho >> 4, i = rho & 15; return 8 * (i >> 2) + 4 * n + (i & 3); }

struct Unit { int pm, pn; };
struct Gemm { const bf16_t* A; const bf16_t* Bt; int M, N, K; };

struct StaticOrder {
    int nM, nN, nwg, G, c;
    __host__ __device__ void init(int M, int N, int G_, int c_) { nM = M / BM; nN = N / BM; nwg = nM * nN; G = G_; c = c_; }
    __host__ __device__ bool next(int i, Unit& u) const {
        const long L = (long)i * G + c; if (L >= nwg) return false;
        int wgid = (int)L; { const int q = nwg / NXCD, r = nwg % NXCD, xcd = wgid % NXCD, off = wgid / NXCD; wgid = (xcd < r ? xcd * (q + 1) : r * (q + 1) + (xcd - r) * q) + off; }
        const int nig = WGM * nN, gid = wgid / nig, fm = gid * WGM, gsz = (nM - fm) < WGM ? (nM - fm) : WGM;
        u.pm = fm + ((wgid % nig) % gsz); u.pn = (wgid % nig) / gsz; return true;
    }
    __device__ __forceinline__ void a_ready(const Unit&) const {}
    __device__ __forceinline__ void done(const Unit&) const {}
};

__device__ __forceinline__ unsigned cvt_pk_bf16(float lo, float hi) { unsigned r; asm volatile("v_cvt_pk_bf16_f32 %0, %1, %2" : "=v"(r) : "v"(lo), "v"(hi)); return r; }
typedef float f32x2 __attribute__((ext_vector_type(2)));
__device__ __forceinline__ float sigm_f(float a) { return __builtin_amdgcn_rcpf(1.0f + __expf(-a)); }
__device__ __forceinline__ float silu_f(float a) { return a * sigm_f(a); }
__device__ __forceinline__ float bf_lo(unsigned w) { return __uint_as_float(w << 16); }
__device__ __forceinline__ float bf_hi(unsigned w) { return __uint_as_float(w & 0xffff0000u); }
struct EpiSwiglu {
    static constexpr bool PERM = true, AFTER_DRAIN = false;
    bf16_t* O; int ldc;
    __device__ __forceinline__ void operator()(const f32x4 (&acc)[2][2][4][2], const Unit& u, int wr, int wc, int fr, int fq) const {
        const int row0 = u.pm * BM + wr * 64 + fr, col0 = u.pn * HALF + wc * 32 + 8 * fq;
#pragma unroll
        for (int ai = 0; ai < 2; ++ai)
#pragma unroll
            for (int m = 0; m < 4; ++m) { bf16_t* rowp = O + (size_t)(row0 + ai * HALF + m * 16) * ldc + col0;
                const f32x4 a0 = acc[ai][0][m][0], a1 = acc[ai][0][m][1], b0 = acc[ai][1][m][0], b1 = acc[ai][1][m][1];
                u32x4 w; w.x = cvt_pk_bf16(silu_f(a0[0]) * b0[0], silu_f(a0[1]) * b0[1]); w.y = cvt_pk_bf16(silu_f(a0[2]) * b0[2], silu_f(a0[3]) * b0[3]);
                w.z = cvt_pk_bf16(silu_f(a1[0]) * b1[0], silu_f(a1[1]) * b1[1]); w.w = cvt_pk_bf16(silu_f(a1[2]) * b1[2], silu_f(a1[3]) * b1[3]);
                *(u32x4*)rowp = w; }
    }
};
struct EpiF32 {
    static constexpr bool PERM = false, AFTER_DRAIN = false;
    float* C; int ldc;
    __device__ __forceinline__ void operator()(const f32x4 (&acc)[2][2][4][2], const Unit& u, int wr, int wc, int fr, int fq) const {
        const int row0 = u.pm * BM + wr * 64 + fr, col0 = u.pn * BM + wc * 32 + 4 * fq;
#pragma unroll
        for (int ai = 0; ai < 2; ++ai)
#pragma unroll
            for (int m = 0; m < 4; ++m) { float* rowp = C + (size_t)(row0 + ai * HALF + m * 16) * ldc + col0;
#pragma unroll
                for (int bj = 0; bj < 2; ++bj)
#pragma unroll
                    for (int n = 0; n < 2; ++n) *(f32x4*)(rowp + bj * HALF + n * 16) = acc[ai][bj][m][n]; }
    }
};
struct EpiZ {
    static constexpr bool PERM = true, AFTER_DRAIN = false;
    bf16_t* Z; int ldc; float* ck; float* cv;
    __device__ __forceinline__ void operator()(const f32x4 (&acc)[2][2][4][2], const Unit& u, int wr, int wc, int fr, int fq) const {
        const int row0 = u.pm * BM + wr * 64 + fr, col0 = u.pn * BM + wc * 32 + 8 * fq;
        const bool isk = (u.pm < 32) && (u.pn >= 36) && (u.pn < 40), isv = (u.pm < 32) && (u.pn >= 40) && (u.pn < 44);
        float* cbase = isk ? ck : cv; const int csub = isk ? 9216 : 10240;
#pragma unroll
        for (int ai = 0; ai < 2; ++ai)
#pragma unroll
            for (int m = 0; m < 4; ++m) { const int r = row0 + ai * HALF + m * 16; bf16_t* rowp = Z + (size_t)r * ldc + col0;
#pragma unroll
                for (int bj = 0; bj < 2; ++bj) { const f32x4 v0 = acc[ai][bj][m][0], v1 = acc[ai][bj][m][1];
                    u32x4 w; w.x = cvt_pk_bf16(v0[0], v0[1]); w.y = cvt_pk_bf16(v0[2], v0[3]); w.z = cvt_pk_bf16(v1[0], v1[1]); w.w = cvt_pk_bf16(v1[2], v1[3]);
                    *(u32x4*)(rowp + bj * HALF) = w;
                    if (isk || isv) { float* dst = cbase + ((size_t)u.pm * 2 * 256 + (size_t)(r & 255)) * 1024 + (col0 + bj * HALF - csub);
                        *(f32x4*)dst = v0; *(f32x4*)(dst + 4) = v1; } } }
    }
};
template <int STAGE> struct EpiMerge {
    static constexpr bool PERM = true, AFTER_DRAIN = false;
    const bf16_t* Zg; int ldz; float* M32; bf16_t* MB; int ldm;
    __device__ __forceinline__ void operator()(const f32x4 (&acc)[2][2][4][2], const Unit& u, int wr, int wc, int fr, int fq) const {
        const int row0 = u.pm * BM + wr * 64 + fr, col0 = u.pn * BM + wc * 32 + 8 * fq;
#pragma unroll
        for (int ai = 0; ai < 2; ++ai)
#pragma unroll
            for (int m = 0; m < 4; ++m) { const int r = row0 + ai * HALF + m * 16;
#pragma unroll
                for (int bj = 0; bj < 2; ++bj) { const int c = col0 + bj * HALF;
                    const u32x4 gw = *(const u32x4*)(Zg + (size_t)r * ldz + c);
                    f32x4 v0 = acc[ai][bj][m][0], v1 = acc[ai][bj][m][1];
                    v0[0] *= sigm_f(bf_lo(gw.x)); v0[1] *= sigm_f(bf_hi(gw.x)); v0[2] *= sigm_f(bf_lo(gw.y)); v0[3] *= sigm_f(bf_hi(gw.y));
                    v1[0] *= sigm_f(bf_lo(gw.z)); v1[1] *= sigm_f(bf_hi(gw.z)); v1[2] *= sigm_f(bf_lo(gw.w)); v1[3] *= sigm_f(bf_hi(gw.w));
                    float* mp = M32 + (size_t)r * ldm + c;
                    if (STAGE > 0) { v0 += *(const f32x4*)mp; v1 += *(const f32x4*)(mp + 4); }
                    if (STAGE < 2) { *(f32x4*)mp = v0; *(f32x4*)(mp + 4) = v1; }
                    else { u32x4 w; w.x = cvt_pk_bf16(v0[0], v0[1]); w.y = cvt_pk_bf16(v0[2], v0[3]); w.z = cvt_pk_bf16(v1[0], v1[1]); w.w = cvt_pk_bf16(v1[2], v1[3]);
                        *(u32x4*)(MB + (size_t)r * ldm + c) = w; } } }
    }
};

template <class Epi, class Sched, bool ALIGN_EPI = false, bool SP2 = false>
__device__ __forceinline__ void gemm_phase(PG8_LAS unsigned char* lds, const Gemm g, const Sched& S, const Epi& E) {
    const int tid = threadIdx.x, wid = __builtin_amdgcn_readfirstlane(tid >> 6), lane = tid & 63, wr = wid >> 2, wc = wid & 3, fr = lane & 15, fq = lane >> 4;
    const int K = g.K, nt = K / BK;
    unsigned voffA[2], voffB[2];
#pragma unroll
    for (int i = 0; i < 2; ++i) { int R, C; stage_rc(tid * 16 + i * 8192, R, C); const int Rb = Epi::PERM ? ((R & ~31) + perm32(R & 31)) : R;
        voffA[i] = (unsigned)(R * K + C) * 2u; voffB[i] = (unsigned)(Rb * K + C) * 2u; }
    const size_t kstep = (size_t)(BK * 2);
    const size_t hstep = (size_t)HALF * K * 2;
    const size_t tstep = 2 * hstep;
    const unsigned ldsw = (unsigned)wid * 1024u;
    const int aoff = lds_byte(wr * 64 + fr, fq * 8), boff = lds_byte(wc * 32 + fr, fq * 8);
#define PG8_SA(b, h) (((b) * 2 + (h)) * HTB)
#define PG8_SB(b, h) ((4 + (b) * 2 + (h)) * HTB)
#define PG8_STAGE(bufoff, gbase, voff) do { _Pragma("unroll") for (int _i = 0; _i < 2; ++_i) \
        __builtin_amdgcn_global_load_lds((const unsigned*)((const char*)(gbase) + (voff)[_i]), (PG8_LAS unsigned*)(lds + (bufoff) + ldsw + _i * 8192), 16, 0, 0); } while (0)
#define PG8_LDA(dst, b, h) do { _Pragma("unroll") for (int m = 0; m < 4; ++m) _Pragma("unroll") for (int k = 0; k < 2; ++k) dst[m][k] = *(const PG8_LAS bf16x8*)(lds + PG8_SA(b, h) + aoff + m * 2048 + k * 1024); } while (0)
#define PG8_LDB(dst, b, h) do { _Pragma("unroll") for (int n = 0; n < 2; ++n) _Pragma("unroll") for (int k = 0; k < 2; ++k) dst[n][k] = *(const PG8_LAS bf16x8*)(lds + PG8_SB(b, h) + boff + n * 2048 + k * 1024); } while (0)
#define PG8_MMA(ai, bj, At, Bt) do { __builtin_amdgcn_s_setprio(1); _Pragma("unroll") for (int m = 0; m < 4; ++m) _Pragma("unroll") for (int n = 0; n < 2; ++n) _Pragma("unroll") for (int k = 0; k < 2; ++k) \
        acc[ai][bj][m][n] = __builtin_amdgcn_mfma_f32_16x16x32_bf16(Bt[n][k], At[m][k], acc[ai][bj][m][n], 0, 0, 0); __builtin_amdgcn_s_setprio(0); } while (0)
#define PG8_WAIT_V(n) asm volatile("s_waitcnt vmcnt(" #n ")" ::: "memory")
#define PG8_WAIT_L(n) asm volatile("s_waitcnt lgkmcnt(" #n ")" ::: "memory")
#define PG8_BAR __builtin_amdgcn_s_barrier()
#define PG8_SCHED __builtin_amdgcn_sched_barrier(0)
    Unit cur, nxt; int ui = 0;
    if (!S.next(0, cur)) return;
    f32x4 acc[2][2][4][2];
#pragma unroll
    for (int a = 0; a < 2; ++a)
#pragma unroll
        for (int b = 0; b < 2; ++b)
#pragma unroll
            for (int m = 0; m < 4; ++m)
#pragma unroll
                for (int n = 0; n < 2; ++n) acc[a][b][m][n] = (f32x4){0.f, 0.f, 0.f, 0.f};
    bf16x8 At[4][2], B0[2][2], B1[2][2];
    const char* cA = (const char*)g.A + (size_t)cur.pm * tstep; const char* cB = (const char*)g.Bt + (size_t)cur.pn * tstep;
    S.a_ready(cur);
    if constexpr (SP2) {
        PG8_STAGE(PG8_SB(0, 0), cB, voffB); PG8_STAGE(PG8_SB(0, 1), cB + hstep, voffB); PG8_STAGE(PG8_SA(0, 0), cA, voffA); PG8_STAGE(PG8_SA(0, 1), cA + hstep, voffA);
        if (wr == 1) PG8_BAR;
        PG8_WAIT_V(2); PG8_BAR;
        PG8_STAGE(PG8_SB(1, 0), cB + kstep, voffB); PG8_STAGE(PG8_SA(1, 0), cA + kstep, voffA); PG8_STAGE(PG8_SB(1, 1), cB + hstep + kstep, voffB);
        PG8_WAIT_V(6); PG8_BAR;
    } else {
        PG8_STAGE(PG8_SB(0, 0), cB, voffB); PG8_STAGE(PG8_SA(0, 0), cA, voffA); PG8_STAGE(PG8_SB(0, 1), cB + hstep, voffB); PG8_STAGE(PG8_SA(0, 1), cA + hstep, voffA);
        if (wr == 1) PG8_BAR;
        PG8_WAIT_V(4); PG8_BAR;
        PG8_STAGE(PG8_SB(1, 0), cB + kstep, voffB); PG8_STAGE(PG8_SA(1, 0), cA + kstep, voffA); PG8_STAGE(PG8_SB(1, 1), cB + hstep + kstep, voffB);
        PG8_WAIT_V(6); PG8_BAR;
    }
    for (;;) {
        const bool has_next = S.next(ui + 1, nxt);
        const char* nA = has_next ? (const char*)g.A + (size_t)nxt.pm * tstep : cA; const char* nB = has_next ? (const char*)g.Bt + (size_t)nxt.pn * tstep : cB;
        for (int t = 0; t < nt; t += 2) {
            const bool last = (t == nt - 2);
            const char* a1 = cA + (size_t)(t + 1) * kstep;
            const char* a2 = last ? nA : cA + (size_t)(t + 2) * kstep; const char* b2 = last ? nB : cB + (size_t)(t + 2) * kstep;
            const char* a3 = a2 + kstep; const char* b3 = b2 + kstep;
            if (last && has_next) S.a_ready(nxt);
            if constexpr (SP2) {
            PG8_LDB(B0, 0, 0); PG8_LDB(B1, 0, 1); PG8_SCHED; PG8_LDA(At, 0, 0); PG8_STAGE(PG8_SA(1, 1), a1 + hstep, voffA);
            PG8_WAIT_V(8); PG8_WAIT_L(0); PG8_BAR; PG8_MMA(0, 0, At, B0); PG8_MMA(0, 1, At, B1); PG8_BAR; PG8_SCHED;
            PG8_LDA(At, 0, 1); PG8_STAGE(PG8_SB(0, 0), b2, voffB); PG8_STAGE(PG8_SB(0, 1), b2 + hstep, voffB); PG8_STAGE(PG8_SA(0, 0), a2, voffA);
            PG8_WAIT_V(8); PG8_WAIT_L(0); PG8_BAR; PG8_MMA(1, 0, At, B0); PG8_MMA(1, 1, At, B1); PG8_BAR; PG8_SCHED;
            PG8_LDB(B0, 1, 0); PG8_LDB(B1, 1, 1); PG8_SCHED; PG8_LDA(At, 1, 0); PG8_STAGE(PG8_SA(0, 1), a2 + hstep, voffA);
            PG8_WAIT_V(8); PG8_WAIT_L(0); PG8_BAR; PG8_MMA(0, 0, At, B0); PG8_MMA(0, 1, At, B1); PG8_BAR; PG8_SCHED;
            PG8_LDA(At, 1, 1); PG8_STAGE(PG8_SB(1, 0), b3, voffB); PG8_STAGE(PG8_SB(1, 1), b3 + hstep, voffB); PG8_STAGE(PG8_SA(1, 0), a3, voffA);
            PG8_WAIT_V(8); PG8_WAIT_L(0); PG8_BAR; PG8_MMA(1, 0, At, B0); PG8_MMA(1, 1, At, B1); PG8_BAR; PG8_SCHED;
            } else {
            PG8_LDB(B0, 0, 0); PG8_SCHED; PG8_LDA(At, 0, 0); PG8_STAGE(PG8_SA(1, 1), a1 + hstep, voffA);
            PG8_WAIT_L(8); PG8_BAR; PG8_WAIT_L(0); PG8_MMA(0, 0, At, B0); PG8_BAR; PG8_SCHED;
            PG8_LDB(B1, 0, 1); PG8_STAGE(PG8_SB(0, 0), b2, voffB);
            PG8_BAR; PG8_WAIT_L(0); PG8_MMA(0, 1, At, B1); PG8_BAR;
            PG8_LDA(At, 0, 1); PG8_STAGE(PG8_SA(0, 0), a2, voffA);
            PG8_BAR; PG8_WAIT_L(0); PG8_MMA(1, 0, At, B0); PG8_BAR; PG8_SCHED;
            PG8_STAGE(PG8_SB(0, 1), b2 + hstep, voffB);
            PG8_WAIT_V(6); PG8_BAR; PG8_MMA(1, 1, At, B1); PG8_BAR;
            PG8_LDB(B0, 1, 0); PG8_SCHED; PG8_LDA(At, 1, 0); PG8_STAGE(PG8_SA(0, 1), a2 + hstep, voffA);
            PG8_WAIT_L(8); PG8_BAR; PG8_WAIT_L(0); PG8_MMA(0, 0, At, B0); PG8_BAR; PG8_SCHED;
            PG8_LDB(B1, 1, 1); PG8_STAGE(PG8_SB(1, 0), b3, voffB);
            PG8_BAR; PG8_WAIT_L(0); PG8_MMA(0, 1, At, B1); PG8_BAR;
            PG8_LDA(At, 1, 1); PG8_STAGE(PG8_SA(1, 0), a3, voffA);
            PG8_BAR; PG8_WAIT_L(0); PG8_MMA(1, 0, At, B0); PG8_BAR; PG8_SCHED;
            PG8_STAGE(PG8_SB(1, 1), b3 + hstep, voffB);
            PG8_WAIT_V(6); PG8_BAR; PG8_MMA(1, 1, At, B1); PG8_BAR;
            }
        }
        if constexpr (ALIGN_EPI) { if (wr == 0) PG8_BAR; }
        if constexpr (!Epi::AFTER_DRAIN) { E(acc, cur, wr, wc, fr, fq); S.done(cur); }
        if (!has_next) break;
#pragma unroll
        for (int a = 0; a < 2; ++a)
#pragma unroll
            for (int b = 0; b < 2; ++b)
#pragma unroll
                for (int m = 0; m < 4; ++m)
#pragma unroll
                    for (int n = 0; n < 2; ++n) acc[a][b][m][n] = (f32x4){0.f, 0.f, 0.f, 0.f};
        cur = nxt; cA = nA; cB = nB; ++ui;
        if constexpr (ALIGN_EPI) { if (wr == 1) PG8_BAR; }
    }
    PG8_WAIT_V(0);
    if constexpr (!ALIGN_EPI) { if (wr == 0) PG8_BAR; }
    PG8_BAR;
    if constexpr (Epi::AFTER_DRAIN) { E.fused(acc, cur, wr, wc, fr, fq, lds, wid, lane); S.done(cur); }
#undef PG8_SA
#undef PG8_SB
#undef PG8_STAGE
#undef PG8_LDA
#undef PG8_LDB
#undef PG8_MMA
#undef PG8_WAIT_V
#undef PG8_WAIT_L
#undef PG8_BAR
#undef PG8_SCHED
}
}

constexpr int NWAVES = 8;
constexpr int D = 2048, FF = 5632, FF2 = 2 * FF, INW = 17408, NMODV = 9, NMODW = 18432;
constexpr int MC = 8192, ML = 8192, M = MC + ML;
constexpr int ZC_RQ = 0, ZC_RK = 1024, ZC_RV = 2048, ZC_RG = 4096, ZC_GU = 6144, ZC_GV = 7168, ZC_NQ = 8192, ZC_NK = 9216, ZC_NV = 10240, ZC_GA = 11264;
constexpr float NORM_EPS = 1e-6f;
constexpr float LOG2E = 1.4426950408889634f;
enum { I_XP = 0, I_XS, I_CK, I_CV, I_SR, I_C, I_CCTX, I_WADA, I_BADA, I_NPRE, I_NPOST, I_FWIN, I_FWOUT, I_WIN, I_RDL, I_GMN, I_GMWS, I_GMBS, I_RPB, I_WBR, I_WBG, I_WBN, I_WOUT, N_IN };
constexpr size_t OUT_X = 0, OUT_CK = 33554432, OUT_CV = 50331648, OUT_ST = 67108864, OUT_TOTAL = 100663296;
constexpr size_t MiB = 1u << 20;
constexpr size_t WS_CTL = 0, CTL_ZERO_BYTES = 1 * MiB;
constexpr size_t WS_ROT = 1 * MiB;
constexpr size_t WS_MOD = 2 * MiB;
constexpr size_t WS_WT = 8 * MiB;
constexpr size_t WT_UP = 0, WT_DN = 88 * MiB, WT_IN = 132 * MiB, WT_BR = 200 * MiB, WT_BG = 208 * MiB, WT_BN = 212 * MiB, WT_OUT = 216 * MiB;
constexpr size_t WS_Z = 232 * MiB;
constexpr size_t WS_Y = 776 * MiB;
constexpr size_t WS_H = 904 * MiB;
constexpr size_t WS_RET = 968 * MiB, WS_GM = 1032 * MiB, WS_NA = 1064 * MiB, WS_END = 1096 * MiB;
constexpr int CW_BAR = 4096;
constexpr int LDS_BYTES = 151552;
constexpr int MISC_OFF = 150528;

#define GAS __attribute__((address_space(1)))
#define LAS __attribute__((address_space(3)))
typedef unsigned short bf16;
typedef unsigned v4u __attribute__((ext_vector_type(4)));
typedef unsigned v2u __attribute__((ext_vector_type(2)));
typedef float f32x4 __attribute__((ext_vector_type(4)));
typedef float f32x2 __attribute__((ext_vector_type(2)));
typedef short bf16x8 __attribute__((ext_vector_type(8)));
typedef short bf16x4 __attribute__((ext_vector_type(4)));
typedef GAS unsigned gu32;
#define LDS_WAIT() asm volatile("s_waitcnt lgkmcnt(0)" ::: "memory")
#define VM_WAIT() asm volatile("s_waitcnt vmcnt(0)" ::: "memory")
__device__ __forceinline__ unsigned pk2(float lo, float hi) { return pg8::cvt_pk_bf16(lo, hi); }
__device__ __forceinline__ float bflo(unsigned w) { return __uint_as_float(w << 16); }
__device__ __forceinline__ float bfhi(unsigned w) { return __uint_as_float(w & 0xffff0000u); }
__device__ __forceinline__ float wave_sum(float v) {
#pragma unroll
    for (int o = 1; o < 64; o <<= 1) v += __shfl_xor(v, o);
    return v;
}
#define MFMA16(a, b, c) __builtin_amdgcn_mfma_f32_16x16x32_bf16((a), (b), (c), 0, 0, 0)
#define TR16(p) __builtin_amdgcn_ds_read_tr16_b64_v4i16((LAS bf16x4*)(p))
__device__ __forceinline__ bf16x8 frag_rk(const LAS bf16* base, int pitch, int row0, int k0, int lane) {
    return *(const LAS bf16x8*)(base + (row0 + (lane & 15)) * pitch + k0 + 8 * (lane >> 4));
}
__device__ __forceinline__ bf16x8 frag_ck2(const LAS bf16* base, int pitch, int rowA, int rowB, int c0, int lane) {
    const int off = (4 * (lane >> 4) + ((lane & 15) >> 2)) * pitch + c0 + 4 * (lane & 3);
    const bf16x4 lo = TR16(base + rowA * pitch + off), hi = TR16(base + rowB * pitch + off);
    return __builtin_shufflevector(lo, hi, 0, 1, 2, 3, 4, 5, 6, 7);
}
__device__ __forceinline__ bf16x8 frag_ck(const LAS bf16* base, int pitch, int k0, int c0, int lane) {
    const LAS bf16* p = base + (k0 + 8 * (lane >> 4) + ((lane & 15) >> 2)) * pitch + c0 + 4 * (lane & 3);
    const bf16x4 lo = TR16(p), hi = TR16(p + 4 * pitch);
    return __builtin_shufflevector(lo, hi, 0, 1, 2, 3, 4, 5, 6, 7);
}
#define RLX_AGENT __ATOMIC_RELAXED, __HIP_MEMORY_SCOPE_AGENT
#define XB_TMO      128
#define XB_XCNT(j)  (256  + 64 * (j))
#define XB_XSUB(j)  (1280 + 64 * (j))
#define XB_XGEN(j)  (2304 + 64 * (j))
#define XB_TOP      3328
#define XB_TOPGEN   3392
#define XCD_BAR_WORDS 3456
#define XB_SPIN_CAP (1u << 18)

__device__ __forceinline__ unsigned xb_ld(unsigned* p)              { return __hip_atomic_load(p, __ATOMIC_RELAXED, __HIP_MEMORY_SCOPE_AGENT); }
__device__ __forceinline__ unsigned xb_add(unsigned* p, unsigned v) { return __hip_atomic_fetch_add(p, v, __ATOMIC_RELAXED, __HIP_MEMORY_SCOPE_AGENT); }
__device__ __forceinline__ unsigned xb_xcc_id() { return (unsigned)__builtin_amdgcn_s_getreg((3 << 11) | 20) & 0xFu; }
#define XB_SPIN(cond, bar) do { unsigned _sp = 0; while (cond) { __builtin_amdgcn_s_sleep(1); \
    if ((++_sp & 255u) == 0u) { if (xb_ld(&(bar)[XB_TMO])) break; if (_sp > XB_SPIN_CAP) { atomicAdd(&(bar)[XB_TMO], 1u); break; } } } } while (0)

struct XcdBarrier {
    unsigned* bar; unsigned x;
    volatile LAS unsigned* st;
};

__device__ __forceinline__ XcdBarrier xcd_barrier_post(unsigned* bar, volatile LAS unsigned* st) {
    XcdBarrier b; b.bar = bar; b.x = xb_xcc_id(); b.st = st;
    if (threadIdx.x == 0) (void)xb_add(&bar[XB_XCNT(b.x)], 1u);
    return b;
}
__device__ __forceinline__ void xcd_barrier_complete(unsigned* bar, unsigned x, unsigned& nloc, unsigned& nx) {
    const unsigned G = gridDim.x * gridDim.y * gridDim.z;
    unsigned sum, cnt, mine, sp = 0u;
    for (;;) {
        sum = 0u; cnt = 0u; mine = 0u;
#pragma unroll
        for (unsigned j = 0; j < 16; ++j) { const unsigned c = xb_ld(&bar[XB_XCNT(j)]); sum += c; cnt += (c > 0u) ? 1u : 0u; mine = (j == x) ? c : mine; }
        if (sum == G) break;
        __builtin_amdgcn_s_sleep(1);
        if ((++sp & 255u) == 0u) { if (xb_ld(&bar[XB_TMO])) break; if (sp > XB_SPIN_CAP) { atomicAdd(&bar[XB_TMO], 1u); break; } }
    }
    nloc = mine > 0u ? mine : 1u; nx = cnt > 0u ? cnt : 1u;
}

__device__ __forceinline__ void xcd_barrier(const XcdBarrier& b) {
    asm volatile("s_waitcnt vmcnt(0)" ::: "memory");
    __syncthreads();
    if (threadIdx.x == 0) {
        unsigned* bar = b.bar;
        __builtin_amdgcn_s_waitcnt(0);
        unsigned nloc = b.st[0], nx = b.st[1];
        if (nloc == 0u) { xcd_barrier_complete(bar, b.x, nloc, nx); b.st[0] = nloc; b.st[1] = nx; }
        const unsigned old = xb_add(&bar[XB_XSUB(b.x)], 1u);
        const unsigned gen = old / nloc;
        if (old + 1u == (gen + 1u) * nloc) {
            __builtin_amdgcn_fence(__ATOMIC_RELEASE, "agent");
            asm volatile("s_waitcnt vmcnt(0)" ::: "memory");
            const unsigned og = xb_add(&bar[XB_TOP], 1u);
            const unsigned tg = og / nx;
            if (og + 1u == (tg + 1u) * nx) xb_add(&bar[XB_TOPGEN], 1u);
            else XB_SPIN(xb_ld(&bar[XB_TOPGEN]) == tg, bar);
            __builtin_amdgcn_fence(__ATOMIC_ACQUIRE, "agent");
            xb_add(&bar[XB_XGEN(b.x)], 1u);
            asm volatile("s_waitcnt vmcnt(0)" ::: "memory");
        } else {
            XB_SPIN(xb_ld(&bar[XB_XGEN(b.x)]) == gen, bar);
            __builtin_amdgcn_fence(__ATOMIC_ACQUIRE, "agent");
            asm volatile("s_waitcnt vmcnt(0)" ::: "memory");
        }
    }
    __syncthreads();
}

struct Args { const float* in[N_IN]; float* out; unsigned char* ws; int ph_lo, ph_hi; };
__device__ __forceinline__ const float* inp(int i) { const float* const __attribute__((address_space(4)))* kp = (const float* const __attribute__((address_space(4)))*)__builtin_amdgcn_kernarg_segment_ptr(); asm volatile("" : "+s"(kp)); return kp[i]; }

__device__ __forceinline__ unsigned char* wsp(const Args& a) { unsigned char* p = a.ws; asm volatile("" : "+s"(p)); return p; }
__device__ __forceinline__ float* outp(const Args& a) { float* p = a.out; asm volatile("" : "+s"(p)); return p; }
__device__ __forceinline__ int up_destrow(int n) { const int half = n >= FF ? 1 : 0; const int j = n - half * FF; return (j >> 7) * 256 + half * 128 + (j & 127); }
template <bool SWI> __device__ __forceinline__ void transpose_item(const float* __restrict__ W, int K, int N, bf16* __restrict__ WT, LAS float* scr, int item, int lane) {
    const int nblk = N / 32, kb = item / nblk, nb = item - kb * nblk, k0 = 64 * kb, n0 = 32 * nb;
#pragma unroll 8
    for (int i = 0; i < 32; ++i) { const int kk = 2 * i + (lane >> 5); scr[kk * 33 + (lane & 31)] = W[(size_t)(k0 + kk) * N + n0 + (lane & 31)]; }
    LDS_WAIT(); asm volatile("" ::: "memory");
    const int r0 = SWI ? up_destrow(n0) : n0;
    const int c = lane & 7;
#pragma unroll
    for (int j = 0; j < 4; ++j) { const int n = (lane >> 3) + 8 * j; const LAS float* s = scr + (8 * c) * 33 + n;
        v4u o; o.x = pk2(s[0 * 33], s[1 * 33]); o.y = pk2(s[2 * 33], s[3 * 33]); o.z = pk2(s[4 * 33], s[5 * 33]); o.w = pk2(s[6 * 33], s[7 * 33]);
        *(v4u*)(WT + (size_t)(r0 + n) * K + k0 + 8 * c) = o; }
    LDS_WAIT(); asm volatile("" ::: "memory");
}
__device__ __forceinline__ void conv_phase(const Args& a, const int l, LAS unsigned char* lds, const int vcu, const int G) {
    int tid = threadIdx.x; asm volatile("" : "+v"(tid)); const int lane = tid & 63, wave = __builtin_amdgcn_readfirstlane(tid >> 6);
    unsigned char* ws = wsp(a);
    if (l == 0) {
        { const int gt = vcu * 512 + tid; if (gt < 64 * 32) { const int pos = gt >> 5, f = gt & 31; const float inv = powf(10000.0f, -(float)(2 * f) / 64.0f); const float ang = (float)pos * inv;
            float s, c; sincosf(ang, &s, &c); ((f32x2*)(ws + WS_ROT))[gt] = (f32x2){c, s}; } }
        LAS float* sc = (LAS float*)lds;
        LAS float* red = (LAS float*)(lds + 73728);
        for (int idx = tid; idx < NMODV * D; idx += 512) { const int v = idx >> 11, k = idx & 2047; const float x = (v == 0) ? inp(I_CCTX)[k] : inp(I_C)[(v - 1) * D + k]; sc[idx] = x / (1.0f + expf(-x)); }
        __syncthreads();
        float* MOD = (float*)(ws + WS_MOD);
        const int half = lane >> 5, ln = lane & 31;
        for (int u = vcu; u < 288; u += G) {
            const int la = u / 144, n0 = (u - la * 144) * 128;
            const float* W = inp(I_WADA) + (size_t)la * D * NMODW + n0 + 4 * ln;
            f32x4 acc[NMODV];
#pragma unroll
            for (int v = 0; v < NMODV; ++v) acc[v] = (f32x4){0.f, 0.f, 0.f, 0.f};
#pragma unroll 8
            for (int kk = 0; kk < 128; ++kk) { const int k = wave * 256 + 2 * kk + half; const f32x4 w = *(const f32x4*)(W + (size_t)k * NMODW);
#pragma unroll
                for (int v = 0; v < NMODV; ++v) { const float s = sc[v * D + k]; acc[v] += w * s; } }
#pragma unroll
            for (int v = 0; v < NMODV; ++v) {
#pragma unroll
                for (int j = 0; j < 4; ++j) acc[v][j] += __shfl_xor(acc[v][j], 32);
                if (half == 0) *(LAS f32x4*)(red + (wave * NMODV + v) * 128 + 4 * ln) = acc[v]; }
            __syncthreads();
            for (int o = tid; o < NMODV * 128; o += 512) { const int v = o >> 7, n = o & 127; float s = 0.f;
#pragma unroll
                for (int w = 0; w < 8; ++w) s += red[(w * NMODV + v) * 128 + n];
                MOD[(size_t)(la * NMODV + v) * NMODW + n0 + n] = s + inp(I_BADA)[la * NMODW + n0 + n]; }
            __syncthreads();
        }
    }
    LAS float* scr = (LAS float*)(lds + wave * 16384);
    const int gw = vcu * NWAVES + wave, NGW = G * NWAVES;
    constexpr int I_UP = 32 * 352, I_DN = 88 * 64, I_INW = 32 * 544, I_BRW = 32 * 64, I_BGW = 16 * 64;
    constexpr int NITEMS = 2 * I_UP + 2 * I_DN + I_INW + 2 * I_BRW + 2 * I_BGW;
    bf16* WT = (bf16*)(ws + WS_WT);
    for (int it = gw; it < NITEMS; it += NGW) {
        int r = it;
        if (r < 2 * I_UP) { const int s = r >= I_UP ? 1 : 0; r -= s * I_UP; transpose_item<true>(inp(I_FWIN) + (size_t)(l * 2 + s) * D * FF2, D, FF2, (bf16*)(ws + WS_WT + WT_UP + s * 44 * MiB), scr, r, lane); continue; } r -= 2 * I_UP;
        if (r < 2 * I_DN) { const int s = r >= I_DN ? 1 : 0; r -= s * I_DN; transpose_item<false>(inp(I_FWOUT) + (size_t)(l * 2 + s) * FF * D, FF, D, (bf16*)(ws + WS_WT + WT_DN + s * 22 * MiB), scr, r, lane); continue; } r -= 2 * I_DN;
        if (r < I_INW) { transpose_item<false>(inp(I_WIN) + (size_t)l * D * INW, D, INW, (bf16*)(ws + WS_WT + WT_IN), scr, r, lane); continue; } r -= I_INW;
        if (r < I_BRW) { transpose_item<false>(inp(I_WBR) + (size_t)l * D * D, D, D, (bf16*)(ws + WS_WT + WT_BR), scr, r, lane); continue; } r -= I_BRW;
        if (r < I_BGW) { transpose_item<false>(inp(I_WBG) + (size_t)l * 1024 * D, 1024, D, (bf16*)(ws + WS_WT + WT_BG), scr, r, lane); continue; } r -= I_BGW;
        if (r < I_BGW) { transpose_item<false>(inp(I_WBN) + (size_t)l * 1024 * D, 1024, D, (bf16*)(ws + WS_WT + WT_BN), scr, r, lane); continue; } r -= I_BGW;
        transpose_item<false>(inp(I_WOUT) + (size_t)l * D * D, D, D, (bf16*)(ws + WS_WT + WT_OUT), scr, r, lane);
    }
    (void)WT;
}

template <bool INIT, bool UPD, bool NXT>
__device__ __forceinline__ void thin_phase(const Args& a, const int lu, const int iu, const float res_w, const int ln_, const int in_, const int vcu, const int G) {
    int tid = threadIdx.x; asm volatile("" : "+v"(tid)); const int lane = tid & 63, wave = __builtin_amdgcn_readfirstlane(tid >> 6);
    const float* MOD = (const float*)(wsp(a) + WS_MOD);
    float* X = outp(a) + OUT_X; const float* Y = (const float*)(wsp(a) + WS_Y); bf16* H = (bf16*)(wsp(a) + WS_H);
    const int gw = vcu * NWAVES + wave, NGW = G * NWAVES;
    for (int blk = gw; blk < M / 8; blk += NGW) {
        const int row0 = blk * 8; const int midx = row0 < MC ? 0 : 1 + ((row0 - MC) >> 10);
        f32x4 ca[8], cb[8], cc[8];
        if (UPD) { const float* gate = MOD + (size_t)(lu * NMODV + midx) * NMODW + (3 * iu + 2) * D; const float* gp = inp(I_NPOST) + (size_t)(lu * 3 + iu) * D;
#pragma unroll
            for (int j = 0; j < 8; ++j) { const int c = 4 * lane + 256 * j; ca[j] = *(const f32x4*)(gate + c) * *(const f32x4*)(gp + c) * res_w; } }
        if (NXT) { const float* sh = MOD + (size_t)(ln_ * NMODV + midx) * NMODW + (3 * in_ + 0) * D; const float* scl = sh + D; const float* gpre = inp(I_NPRE) + (size_t)(ln_ * 3 + in_) * D;
#pragma unroll
            for (int j = 0; j < 8; ++j) { const int c = 4 * lane + 256 * j; cb[j] = *(const f32x4*)(gpre + c) * (*(const f32x4*)(scl + c) + 1.0f); cc[j] = *(const f32x4*)(sh + c); } }
        for (int rr = 0; rr < 8; ++rr) {
            const int row = row0 + rr;
            const float* xin = INIT ? (row < MC ? inp(I_XP) + (size_t)row * D : inp(I_XS) + (size_t)(row - MC) * D) : X + (size_t)row * D;
            f32x4 x[8];
#pragma unroll
            for (int j = 0; j < 8; ++j) x[j] = *(const f32x4*)(xin + 4 * lane + 256 * j);
            if (UPD) { f32x4 y[8]; float ss = 0.f;
#pragma unroll
                for (int j = 0; j < 8; ++j) { y[j] = *(const f32x4*)(Y + (size_t)row * D + 4 * lane + 256 * j); ss += (y[j][0] * y[j][0] + y[j][1] * y[j][1]) + (y[j][2] * y[j][2] + y[j][3] * y[j][3]); }
                const float rstd = 1.0f / sqrtf(wave_sum(ss) * (1.0f / D) + NORM_EPS);
#pragma unroll
                for (int j = 0; j < 8; ++j) x[j] += ca[j] * (y[j] * rstd); }
            if (UPD || INIT) {
#pragma unroll
                for (int j = 0; j < 8; ++j) *(f32x4*)(X + (size_t)row * D + 4 * lane + 256 * j) = x[j]; }
            if (NXT) { float ss = 0.f;
#pragma unroll
                for (int j = 0; j < 8; ++j) ss += (x[j][0] * x[j][0] + x[j][1] * x[j][1]) + (x[j][2] * x[j][2] + x[j][3] * x[j][3]);
                const float rstd = 1.0f / sqrtf(wave_sum(ss) * (1.0f / D) + NORM_EPS);
#pragma unroll
                for (int j = 0; j < 8; ++j) { const f32x4 h = (x[j] * rstd) * cb[j] + cc[j]; v2u w; w.x = pk2(h[0], h[1]); w.y = pk2(h[2], h[3]);
                    *(v2u*)(H + (size_t)row * D + 4 * lane + 256 * j) = w; } }
        }
    }
}

constexpr int PK = 136, PV = 264;
__device__ __forceinline__ float log_decay(const Args& a, int l, int dir, int h) { const float x = inp(I_RDL)[(l * 2 + dir) * 8 + h]; return -log1pf(expf(-x)); }

template <int WMODE>
__device__ __forceinline__ void stage_qk(LAS bf16* dst, const bf16* Z, const float* ROT, const size_t tok0, const int col0, const bool rotary, const int t0, const float wscale, const float lgw, const int tid) {
#pragma unroll
    for (int it = 0; it < 2; ++it) {
        const int item = tid + 512 * it;
        const int j = item >> 3, hf = (item >> 2) & 1, u = item & 3;
        const int c1 = 64 * hf + 8 * u, c2 = c1 + 32;
        const bf16* src = Z + (tok0 + j) * INW + col0;
        const v4u w1 = *(const v4u*)(src + c1), w2 = *(const v4u*)(src + c2);
        float x1[8], x2[8];
        x1[0] = bflo(w1.x); x1[1] = bfhi(w1.x); x1[2] = bflo(w1.y); x1[3] = bfhi(w1.y); x1[4] = bflo(w1.z); x1[5] = bfhi(w1.z); x1[6] = bflo(w1.w); x1[7] = bfhi(w1.w);
        x2[0] = bflo(w2.x); x2[1] = bfhi(w2.x); x2[2] = bflo(w2.y); x2[3] = bfhi(w2.y); x2[4] = bflo(w2.z); x2[5] = bfhi(w2.z); x2[6] = bflo(w2.w); x2[7] = bfhi(w2.w);
        float wj = wscale;
        if (WMODE == 1) wj *= expf(lgw * (float)(127 - j));
        if (WMODE == 2) wj *= expf(lgw * (float)j);
        float o1[8], o2[8];
        if (rotary) { const int t = t0 + j; const int pos = hf == 0 ? (t >> 6) : (t & 63); const f32x4* rp = (const f32x4*)(ROT + (size_t)(pos * 32 + 8 * u) * 2);
#pragma unroll
            for (int e2 = 0; e2 < 4; ++e2) { const f32x4 cs = rp[e2];
                o1[2 * e2] = (x1[2 * e2] * cs[0] - x2[2 * e2] * cs[1]) * wj; o2[2 * e2] = (x1[2 * e2] * cs[1] + x2[2 * e2] * cs[0]) * wj;
                o1[2 * e2 + 1] = (x1[2 * e2 + 1] * cs[2] - x2[2 * e2 + 1] * cs[3]) * wj; o2[2 * e2 + 1] = (x1[2 * e2 + 1] * cs[3] + x2[2 * e2 + 1] * cs[2]) * wj; } }
        else {
#pragma unroll
            for (int e = 0; e < 8; ++e) { o1[e] = x1[e] * wj; o2[e] = x2[e] * wj; } }
        v4u p1, p2; p1.x = pk2(o1[0], o1[1]); p1.y = pk2(o1[2], o1[3]); p1.z = pk2(o1[4], o1[5]); p1.w = pk2(o1[6], o1[7]);
        p2.x = pk2(o2[0], o2[1]); p2.y = pk2(o2[2], o2[3]); p2.z = pk2(o2[4], o2[5]); p2.w = pk2(o2[6], o2[7]);
        *(LAS v4u*)(dst + j * PK + c1) = p1; *(LAS v4u*)(dst + j * PK + c2) = p2;
    }
}
template <int ROWS, int COLS> __device__ __forceinline__ void stage_copy(LAS bf16* dst, const int pitch, const bf16* src, const size_t ld, const int t, const int nt) {
    constexpr int CPR = COLS / 8;
    for (int c = t; c < ROWS * CPR; c += nt) { const int r = c / CPR, cc = c - r * CPR; *(LAS v4u*)(dst + r * pitch + 8 * cc) = *(const v4u*)(src + (size_t)r * ld + 8 * cc); }
}

__device__ __forceinline__ size_t st_index(int grp, int b, int h, int n, int dir) { return grp ? (size_t)1024 + ((size_t)((b * 8 + h) * 8 + n)) * 2 + dir : ((size_t)((b * 8 + h) * 2 + n)) * 2 + dir; }
__device__ __forceinline__ void ret_chain(const Args& a, const int l, LAS unsigned char* lds, const int grp, const int b, const int h, const int dir) {
    int tid = threadIdx.x; asm volatile("" : "+v"(tid)); const int lane = tid & 63, wave = __builtin_amdgcn_readfirstlane(tid >> 6);
    const bf16* Z = (const bf16*)(wsp(a) + WS_Z); const float* ROT = (const float*)(wsp(a) + WS_ROT); bf16* ST = (bf16*)(wsp(a) + WS_Y);
    const int NCH = grp ? 8 : 2; const size_t rowbase = grp ? (size_t)MC + (size_t)b * 1024 : (size_t)b * 256;
    LAS bf16* Kw = (LAS bf16*)lds; LAS bf16* Vs = Kw + 128 * PK;
    const float lg = log_decay(a, l, dir, h); const float gch = expf(lg * 128.0f);
    const int g4 = 4 * (lane >> 4), li = lane & 15;
    f32x4 acc[8][2];
    if (grp) { const float* p = inp(I_SR) + ((size_t)(((b * 2 + l) * 2 + dir) * 8 + h)) * 128 * 256 + g4 * 256 + 32 * wave + li;
#pragma unroll
        for (int mt = 0; mt < 8; ++mt) {
#pragma unroll
            for (int nt = 0; nt < 2; ++nt)
#pragma unroll
                for (int r = 0; r < 4; ++r) acc[mt][nt][r] = p[r * 256 + 16 * nt];
            p += 16 * 256; asm volatile("" : "+v"(p)); } }
    else {
#pragma unroll
        for (int mt = 0; mt < 8; ++mt)
#pragma unroll
            for (int nt = 0; nt < 2; ++nt) acc[mt][nt] = (f32x4){0.f, 0.f, 0.f, 0.f}; }
    for (int step = 0; step < NCH; ++step) {
        const int n = dir ? NCH - 1 - step : step;
        __syncthreads();
        if (dir == 0) stage_qk<1>(Kw, Z, ROT, rowbase + (size_t)n * 128, ZC_RK + h * 128, grp != 0, n * 128, 0.08838834764831845f, lg, tid);
        else          stage_qk<2>(Kw, Z, ROT, rowbase + (size_t)n * 128, ZC_RK + h * 128, grp != 0, n * 128, 0.08838834764831845f, lg, tid);
        stage_copy<128, 256>(Vs, PV, Z + (rowbase + (size_t)n * 128) * INW + ZC_RV + h * 256, INW, tid, 512);
        bf16* st = ST + st_index(grp, b, h, n, dir) * 32768;
#pragma unroll
        for (int mt = 0; mt < 8; ++mt)
#pragma unroll
            for (int nt = 0; nt < 2; ++nt) { v2u w; w.x = pk2(acc[mt][nt][0], acc[mt][nt][1]); w.y = pk2(acc[mt][nt][2], acc[mt][nt][3]);
                *(v2u*)(st + (size_t)(32 * wave + 16 * nt + li) * 128 + 16 * mt + g4) = w; acc[mt][nt] *= gch; }
        __syncthreads();
#pragma unroll 1
        for (int ks = 0; ks < 4; ++ks) { bf16x8 bv[2];
#pragma unroll
            for (int nt = 0; nt < 2; ++nt) bv[nt] = frag_ck(Vs, PV, 32 * ks, 32 * wave + 16 * nt, lane);
#pragma unroll
            for (int mt = 0; mt < 8; ++mt) { const bf16x8 ak = frag_ck(Kw, PK, 32 * ks, 16 * mt, lane);
#pragma unroll
                for (int nt = 0; nt < 2; ++nt) acc[mt][nt] = MFMA16(ak, bv[nt], acc[mt][nt]); } }
    }
    if (!grp) { float* p = outp(a) + OUT_ST + ((size_t)(((b * 2 + l) * 2 + dir) * 8 + h)) * 128 * 256 + g4 * 256 + 32 * wave + li;
#pragma unroll
        for (int mt = 0; mt < 8; ++mt) {
#pragma unroll
            for (int nt = 0; nt < 2; ++nt)
#pragma unroll
                for (int r = 0; r < 4; ++r) p[r * 256 + 16 * nt] = acc[mt][nt][r];
            p += 16 * 256; asm volatile("" : "+v"(p)); } }
}

__device__ __forceinline__ void ret_out_unit(const Args& a, const int l, LAS unsigned char* lds, const int grp, const int b, const int h, const int n) {
    int tid = threadIdx.x; asm volatile("" : "+v"(tid)); const int lane = tid & 63, wave = __builtin_amdgcn_readfirstlane(tid >> 6);
    const bf16* Z = (const bf16*)(wsp(a) + WS_Z); const float* ROT = (const float*)(wsp(a) + WS_ROT); const bf16* ST = (const bf16*)(wsp(a) + WS_Y); bf16* RET = (bf16*)(wsp(a) + WS_RET);
    const size_t tok0 = (grp ? (size_t)MC + (size_t)b * 1024 : (size_t)b * 256) + (size_t)n * 128;
    LAS bf16* Qs = (LAS bf16*)lds; LAS bf16* KP = Qs + 128 * PK; LAS bf16* Vs = KP + 128 * PK; LAS float* RED = (LAS float*)(Vs + 128 * PV);
    const float l2f = log_decay(a, l, 0, h) * LOG2E, l2b = log_decay(a, l, 1, h) * LOG2E;
    const int g4 = 4 * (lane >> 4), li = lane & 15;
    __syncthreads();
    stage_qk<0>(Qs, Z, ROT, tok0, ZC_RQ + h * 128, grp != 0, n * 128, 1.0f, 0.f, tid);
    stage_qk<0>(KP, Z, ROT, tok0, ZC_RK + h * 128, grp != 0, n * 128, 0.08838834764831845f, 0.f, tid);
    stage_copy<128, 256>(Vs, PV, Z + tok0 * INW + ZC_RV + h * 256, INW, tid, 512);
    __syncthreads();
    { f32x4 s[8];
#pragma unroll
        for (int mt = 0; mt < 8; ++mt) s[mt] = (f32x4){0.f, 0.f, 0.f, 0.f};
#pragma unroll 1
        for (int ks = 0; ks < 4; ++ks) { const bf16x8 bq = frag_rk(Qs, PK, 16 * wave, 32 * ks, lane);
#pragma unroll
            for (int mt = 0; mt < 8; ++mt) s[mt] = MFMA16(frag_rk(KP, PK, 16 * mt, 32 * ks, lane), bq, s[mt]); }
        const int i = 16 * wave + li;
        __syncthreads();
#pragma unroll
        for (int mt = 0; mt < 8; ++mt) { float pv[4];
#pragma unroll
            for (int r = 0; r < 4; ++r) { const int j = 16 * mt + g4 + r; const float dij = (float)(i - j);
                const float w = (dij >= 0.f ? __builtin_amdgcn_exp2f(l2f * dij) : 0.f) + (dij <= 0.f ? __builtin_amdgcn_exp2f(-l2b * dij) : 0.f); pv[r] = s[mt][r] * w; }
            v2u w2; w2.x = pk2(pv[0], pv[1]); w2.y = pk2(pv[2], pv[3]); *(LAS v2u*)(KP + i * PK + 16 * mt + g4) = w2; }
    }
    __syncthreads();
    f32x4 o[2][8];
#pragma unroll
    for (int mt = 0; mt < 2; ++mt)
#pragma unroll
        for (int nt = 0; nt < 8; ++nt) o[mt][nt] = (f32x4){0.f, 0.f, 0.f, 0.f};
#pragma unroll
    for (int dd = 0; dd < 2; ++dd) {
        const bf16* st = ST + st_index(grp, b, h, n, dd) * 32768;
#pragma unroll 1
        for (int ks = 0; ks < 4; ++ks) { bf16x8 af[2];
#pragma unroll
            for (int mt = 0; mt < 2; ++mt) af[mt] = *(const bf16x8*)(st + (size_t)(32 * wave + 16 * mt + li) * 128 + 32 * ks + 2 * g4);
#pragma unroll
            for (int nt = 0; nt < 8; ++nt) { const bf16x8 bq = frag_rk(Qs, PK, 16 * nt, 32 * ks, lane);
#pragma unroll
                for (int mt = 0; mt < 2; ++mt) o[mt][nt] = MFMA16(af[mt], bq, o[mt][nt]); } }
#pragma unroll
        for (int nt = 0; nt < 8; ++nt) { const float fi = (float)(16 * nt + li);
            const float sc = dd == 0 ? __builtin_amdgcn_exp2f(l2f * (fi + 1.0f) - l2b * (128.0f - fi)) : __builtin_amdgcn_exp2f(l2b * (128.0f - fi));
#pragma unroll
            for (int mt = 0; mt < 2; ++mt) o[mt][nt] *= sc; }
    }
#pragma unroll 1
    for (int ks = 0; ks < 4; ++ks) { bf16x8 av[2];
#pragma unroll
        for (int mt = 0; mt < 2; ++mt) av[mt] = frag_ck(Vs, PV, 32 * ks, 32 * wave + 16 * mt, lane);
#pragma unroll
        for (int nt = 0; nt < 8; ++nt) { const bf16x8 bp = frag_rk(KP, PK, 16 * nt, 32 * ks, lane);
#pragma unroll
            for (int mt = 0; mt < 2; ++mt) o[mt][nt] = MFMA16(av[mt], bp, o[mt][nt]); } }
#pragma unroll
    for (int nt = 0; nt < 8; ++nt) { float ss = 0.f;
#pragma unroll
        for (int mt = 0; mt < 2; ++mt) ss += (o[mt][nt][0] * o[mt][nt][0] + o[mt][nt][1] * o[mt][nt][1]) + (o[mt][nt][2] * o[mt][nt][2] + o[mt][nt][3] * o[mt][nt][3]);
        ss += __shfl_xor(ss, 16); ss += __shfl_xor(ss, 32);
        if (lane < 16) RED[wave * 128 + 16 * nt + lane] = ss; }
    __syncthreads();
#pragma unroll
    for (int nt = 0; nt < 8; ++nt) { const int i = 16 * nt + li; float tot = 0.f;
#pragma unroll
        for (int w = 0; w < 8; ++w) tot += RED[w * 128 + i];
        const float rstd = 1.0f / sqrtf(tot * (1.0f / 256.0f) + NORM_EPS);
        const bf16* gp = Z + (tok0 + i) * INW + ZC_RG + h * 256 + 32 * wave + g4; bf16* op = RET + (tok0 + i) * D + h * 256 + 32 * wave + g4;
#pragma unroll
        for (int mt = 0; mt < 2; ++mt) { const v2u gw = *(const v2u*)(gp + 16 * mt); const f32x4 v = o[mt][nt] * rstd;
            v2u w; w.x = pk2(v[0] * pg8::silu_f(bflo(gw.x)), v[1] * pg8::silu_f(bfhi(gw.x))); w.y = pk2(v[2] * pg8::silu_f(bflo(gw.y)), v[3] * pg8::silu_f(bfhi(gw.y)));
            *(v2u*)(op + 16 * mt) = w; } }
}

__device__ __forceinline__ void gmlp_unit(const Args& a, const int l, LAS unsigned char* lds, const int grp, const int b, const int n, const int g) {
    int tid = threadIdx.x; asm volatile("" : "+v"(tid)); const int lane = tid & 63, wave = __builtin_amdgcn_readfirstlane(tid >> 6);
    const bf16* Z = (const bf16*)(wsp(a) + WS_Z); bf16* GMo = (bf16*)(wsp(a) + WS_GM);
    const size_t tok0 = (grp ? (size_t)MC + (size_t)b * 1024 : (size_t)b * 256) + (size_t)n * 128;
    LAS bf16* VN = (LAS bf16*)lds; LAS bf16* WS = VN + 128 * PV; LAS f32x2* STAT = (LAS f32x2*)(WS + 128 * PK);
    const int g4 = 4 * (lane >> 4), li = lane & 15;
    __syncthreads();
    for (int tt = 0; tt < 16; ++tt) { const int j = 16 * wave + tt; const bf16* vp = Z + (tok0 + j) * INW + ZC_GV;
        const v4u w1 = *(const v4u*)(vp + 8 * lane), w2 = *(const v4u*)(vp + 512 + 8 * lane);
        float x[16]; x[0] = bflo(w1.x); x[1] = bfhi(w1.x); x[2] = bflo(w1.y); x[3] = bfhi(w1.y); x[4] = bflo(w1.z); x[5] = bfhi(w1.z); x[6] = bflo(w1.w); x[7] = bfhi(w1.w);
        x[8] = bflo(w2.x); x[9] = bfhi(w2.x); x[10] = bflo(w2.y); x[11] = bfhi(w2.y); x[12] = bflo(w2.z); x[13] = bfhi(w2.z); x[14] = bflo(w2.w); x[15] = bfhi(w2.w);
        float s = 0.f;
#pragma unroll
        for (int e = 0; e < 16; ++e) s += x[e];
        const float mean = wave_sum(s) * (1.0f / 1024.0f); float q = 0.f;
#pragma unroll
        for (int e = 0; e < 16; ++e) { const float d = x[e] - mean; q += d * d; }
        const float rstd = 1.0f / sqrtf(wave_sum(q) * (1.0f / 1024.0f) + NORM_EPS);
        if (lane == 0) STAT[j] = (f32x2){mean, rstd}; }
    { const float* wsrc = inp(I_GMWS) + (size_t)(l * 4 + g) * 128 * 128;
        for (int c = tid; c < 128 * 32; c += 512) { const int r = c >> 5, cc = c & 31; const f32x4 v = *(const f32x4*)(wsrc + r * 128 + 4 * cc); v2u w; w.x = pk2(v[0], v[1]); w.y = pk2(v[2], v[3]); *(LAS v2u*)(WS + r * PK + 4 * cc) = w; } }
    __syncthreads();
    { const float* gn = inp(I_GMN) + l * 1024 + g * 256;
        for (int c = tid; c < 128 * 32; c += 512) { const int j = c >> 5, cc = c & 31; const v4u w1 = *(const v4u*)(Z + (tok0 + j) * INW + ZC_GV + g * 256 + 8 * cc);
            const f32x2 st = STAT[j]; const f32x4 n0 = *(const f32x4*)(gn + 8 * cc), n1 = *(const f32x4*)(gn + 8 * cc + 4);
            v4u o; o.x = pk2((bflo(w1.x) - st.x) * st.y * n0[0], (bfhi(w1.x) - st.x) * st.y * n0[1]); o.y = pk2((bflo(w1.y) - st.x) * st.y * n0[2], (bfhi(w1.y) - st.x) * st.y * n0[3]);
            o.z = pk2((bflo(w1.z) - st.x) * st.y * n1[0], (bfhi(w1.z) - st.x) * st.y * n1[1]); o.w = pk2((bflo(w1.w) - st.x) * st.y * n1[2], (bfhi(w1.w) - st.x) * st.y * n1[3]);
            *(LAS v4u*)(VN + j * PV + 8 * cc) = o; } }
    __syncthreads();
    f32x4 o[2][8];
#pragma unroll
    for (int mt = 0; mt < 2; ++mt)
#pragma unroll
        for (int nt = 0; nt < 8; ++nt) o[mt][nt] = (f32x4){0.f, 0.f, 0.f, 0.f};
#pragma unroll 1
    for (int ks = 0; ks < 4; ++ks) { bf16x8 av[2];
#pragma unroll
        for (int mt = 0; mt < 2; ++mt) av[mt] = frag_ck(VN, PV, 32 * ks, 32 * wave + 16 * mt, lane);
#pragma unroll
        for (int nt = 0; nt < 8; ++nt) { const bf16x8 bw = frag_rk(WS, PK, 16 * nt, 32 * ks, lane);
#pragma unroll
            for (int mt = 0; mt < 2; ++mt) o[mt][nt] = MFMA16(av[mt], bw, o[mt][nt]); } }
#pragma unroll
    for (int nt = 0; nt < 8; ++nt) { const int i = 16 * nt + li; const float bias = inp(I_GMBS)[(l * 4 + g) * 128 + i];
        const bf16* up = Z + (tok0 + i) * INW + ZC_GU + g * 256 + 32 * wave + g4; bf16* op = GMo + (tok0 + i) * 1024 + g * 256 + 32 * wave + g4;
#pragma unroll
        for (int mt = 0; mt < 2; ++mt) { const v2u uw = *(const v2u*)(up + 16 * mt); const f32x4 v = o[mt][nt] + bias;
            v2u w; w.x = pk2(v[0] * bflo(uw.x), v[1] * bfhi(uw.x)); w.y = pk2(v[2] * bflo(uw.y), v[3] * bfhi(uw.y)); *(v2u*)(op + 16 * mt) = w; } }
}

template <int NT, bool LOCAL>
__device__ __forceinline__ void attn_chunk(const LAS bf16* KT, const LAS bf16* VT, const bf16x8 (&qf)[4], f32x4 (&o)[8], float& m, float& lsum, const int lane,
                                           const int cs, const float* rpbh, const int roff0, const int qc) {
    const int g4 = 4 * (lane >> 4);
    f32x4 s[NT];
#pragma unroll
    for (int kt = 0; kt < NT; ++kt) { const int row0 = LOCAL ? 64 * (kt >> 1) + cs + 16 * (kt & 1) : 16 * kt; s[kt] = (f32x4){0.f, 0.f, 0.f, 0.f};
#pragma unroll
        for (int ks = 0; ks < 4; ++ks) s[kt] = MFMA16(frag_rk(KT, PK, row0, 32 * ks, lane), qf[ks], s[kt]); }
    const float sc2 = 0.08838834764831845f * LOG2E;
    float cmax = -1e30f;
#pragma unroll
    for (int kt = 0; kt < NT; ++kt)
#pragma unroll
        for (int r = 0; r < 4; ++r) { float v = s[kt][r] * sc2;
            if (LOCAL) { const int kc = cs + 16 * (kt & 1) + g4 + r; const int cst = min(max(qc - 8, 0), 48); const bool valid = (kc >= cst) && (kc < cst + 16);
                const float bias = rpbh[(roff0 + (kt >> 1)) * 31 + min(max(kc - qc + 15, 0), 30)]; v = valid ? v + bias * LOG2E : -1e30f; }
            s[kt][r] = v; cmax = fmaxf(cmax, v); }
    cmax = fmaxf(cmax, __shfl_xor(cmax, 16)); cmax = fmaxf(cmax, __shfl_xor(cmax, 32));
    const float mnew = fmaxf(m, cmax), alpha = __builtin_amdgcn_exp2f(m - mnew); m = mnew;
    float csum = 0.f;
#pragma unroll
    for (int kt = 0; kt < NT; ++kt)
#pragma unroll
        for (int r = 0; r < 4; ++r) { const float p = __builtin_amdgcn_exp2f(s[kt][r] - mnew); s[kt][r] = p; csum += p; }
    csum += __shfl_xor(csum, 16); csum += __shfl_xor(csum, 32);
    lsum = lsum * alpha + csum;
#pragma unroll
    for (int et = 0; et < 8; ++et) o[et] *= alpha;
#pragma unroll
    for (int pr = 0; pr < NT / 2; ++pr) {
        const int rowA = LOCAL ? 64 * pr + cs : 32 * pr, rowB = rowA + 16;
        v4u pw; pw.x = pk2(s[2 * pr][0], s[2 * pr][1]); pw.y = pk2(s[2 * pr][2], s[2 * pr][3]); pw.z = pk2(s[2 * pr + 1][0], s[2 * pr + 1][1]); pw.w = pk2(s[2 * pr + 1][2], s[2 * pr + 1][3]);
        const bf16x8 pb = __builtin_bit_cast(bf16x8, pw);
#pragma unroll
        for (int et = 0; et < 8; ++et) o[et] = MFMA16(frag_ck2(VT, PK, rowA, rowB, 16 * et, lane), pb, o[et]);
    }
}
__device__ __forceinline__ void attn_dense_unit(const Args& a, LAS unsigned char* lds, const int b, const int h, const int qb) {
    int tid = threadIdx.x; asm volatile("" : "+v"(tid)); const int lane = tid & 63, wave = __builtin_amdgcn_readfirstlane(tid >> 6);
    const bf16* Z = (const bf16*)(wsp(a) + WS_Z); bf16* NAo = (bf16*)(wsp(a) + WS_NA);
    LAS bf16* KT = (LAS bf16*)lds; LAS bf16* VT = KT + 128 * PK;
    const int g4 = 4 * (lane >> 4), li = lane & 15;
    const size_t qtok = (size_t)b * 256 + (size_t)qb * 128 + 16 * wave + li;
    bf16x8 qf[4];
#pragma unroll
    for (int ks = 0; ks < 4; ++ks) qf[ks] = *(const bf16x8*)(Z + qtok * INW + ZC_NQ + h * 128 + 32 * ks + 2 * g4);
    f32x4 o[8];
#pragma unroll
    for (int et = 0; et < 8; ++et) o[et] = (f32x4){0.f, 0.f, 0.f, 0.f};
    float m = -1e30f, lsum = 0.f;
    for (int ch = 0; ch < 2; ++ch) {
        __syncthreads();
        const bf16* src = Z + ((size_t)b * 256 + (size_t)ch * 128) * INW + h * 128;
        stage_copy<128, 128>(KT, PK, src + ZC_NK, INW, tid, 512); stage_copy<128, 128>(VT, PK, src + ZC_NV, INW, tid, 512);
        __syncthreads();
        attn_chunk<8, false>(KT, VT, qf, o, m, lsum, lane, 0, nullptr, 0, 0);
    }
    const float inv = 1.0f / lsum;
    bf16* op = NAo + qtok * 1024 + h * 128 + g4;
#pragma unroll
    for (int et = 0; et < 8; ++et) { v2u w; w.x = pk2(o[et][0] * inv, o[et][1] * inv); w.y = pk2(o[et][2] * inv, o[et][3] * inv); *(v2u*)(op + 16 * et) = w; }
}
__device__ __forceinline__ void attn_na_unit(const Args& a, const int l, LAS unsigned char* lds, const int b, const int r, const int hp) {
    int tid = threadIdx.x; asm volatile("" : "+v"(tid)); const int lane = tid & 63, wave = __builtin_amdgcn_readfirstlane(tid >> 6);
    const bf16* Z = (const bf16*)(wsp(a) + WS_Z); bf16* NAo = (bf16*)(wsp(a) + WS_NA);
    const int hg = wave >> 2, h = 2 * hp + hg, qa = wave & 3, gt = tid & 255;
    LAS bf16* KT = (LAS bf16*)lds + hg * (2 * 128 * PK); LAS bf16* VT = KT + 128 * PK;
    const int g4 = 4 * (lane >> 4), li = lane & 15;
    const int qc = 16 * qa + li;
    const size_t qtok = (size_t)MC + (size_t)b * 1024 + (size_t)r * 64 + qc;
    const int cs = qa == 0 ? 0 : (qa == 1 ? 8 : (qa == 2 ? 24 : 32));
    const int rs = min(max(r - 4, 0), 8);
    const float* rpbh = inp(I_RPB) + (size_t)(l * 8 + h) * 15 * 31;
    bf16x8 qf[4];
#pragma unroll
    for (int ks = 0; ks < 4; ++ks) qf[ks] = *(const bf16x8*)(Z + qtok * INW + ZC_NQ + h * 128 + 32 * ks + 2 * g4);
    f32x4 o[8];
#pragma unroll
    for (int et = 0; et < 8; ++et) o[et] = (f32x4){0.f, 0.f, 0.f, 0.f};
    float m = -1e30f, lsum = 0.f;
    for (int ch = 0; ch < 4; ++ch) {
        __syncthreads();
        const bf16* src = Z + ((size_t)MC + (size_t)b * 1024 + (size_t)(rs + 2 * ch) * 64) * INW + h * 128;
        stage_copy<128, 128>(KT, PK, src + ZC_NK, INW, gt, 256); stage_copy<128, 128>(VT, PK, src + ZC_NV, INW, gt, 256);
        __syncthreads();
        attn_chunk<4, true>(KT, VT, qf, o, m, lsum, lane, cs, rpbh, rs + 2 * ch - r + 7, qc);
    }
    for (int ch = 0; ch < 2; ++ch) {
        __syncthreads();
        const float* ksrc = inp(I_CK) + ((size_t)((b * 2 + l) * 256 + ch * 128) * 8 + h) * 128;
        const float* vsrc = inp(I_CV) + ((size_t)((b * 2 + l) * 256 + ch * 128) * 8 + h) * 128;
        for (int c = gt; c < 128 * 16; c += 256) { const int rr = c >> 4, cc = c & 15;
            const f32x4 k0 = *(const f32x4*)(ksrc + (size_t)rr * 1024 + 8 * cc), k1 = *(const f32x4*)(ksrc + (size_t)rr * 1024 + 8 * cc + 4);
            const f32x4 v0 = *(const f32x4*)(vsrc + (size_t)rr * 1024 + 8 * cc), v1 = *(const f32x4*)(vsrc + (size_t)rr * 1024 + 8 * cc + 4);
            v4u kw, vw; kw.x = pk2(k0[0], k0[1]); kw.y = pk2(k0[2], k0[3]); kw.z = pk2(k1[0], k1[1]); kw.w = pk2(k1[2], k1[3]);
            vw.x = pk2(v0[0], v0[1]); vw.y = pk2(v0[2], v0[3]); vw.z = pk2(v1[0], v1[1]); vw.w = pk2(v1[2], v1[3]);
            *(LAS v4u*)(KT + rr * PK + 8 * cc) = kw; *(LAS v4u*)(VT + rr * PK + 8 * cc) = vw; }
        __syncthreads();
        attn_chunk<8, false>(KT, VT, qf, o, m, lsum, lane, 0, nullptr, 0, 0);
    }
    const float inv = 1.0f / lsum;
    bf16* op = NAo + qtok * 1024 + h * 128 + g4;
#pragma unroll
    for (int et = 0; et < 8; ++et) { v2u w; w.x = pk2(o[et][0] * inv, o[et][1] * inv); w.y = pk2(o[et][2] * inv, o[et][3] * inv); *(v2u*)(op + 16 * et) = w; }
}
#ifndef NLAYER_LOOP
#define NLAYER_LOOP 2
#endif
#ifndef NSUB_LOOP
#define NSUB_LOOP 2
#endif
#ifndef EN_CONV
#define EN_CONV 1
#endif
#ifndef EN_THIN
#define EN_THIN 1
#endif
#ifndef EN_GEMM
#define EN_GEMM 1
#endif
#ifndef EN_R1
#define EN_R1 1
#endif
#ifndef EN_GM
#define EN_GM 1
#endif
#ifndef EN_AD
#define EN_AD 1
#endif
#ifndef EN_AN
#define EN_AN 1
#endif
#ifndef EN_R2
#define EN_R2 1
#endif

#ifndef MK_SPLIT
#define MK_SPLIT 0
#endif
constexpr int NPH = 14;
enum { PH_CONV = 0, PH_INIT, PH_UP0, PH_DN0, PH_THA, PH_IN, PH_MIX1, PH_MIX2, PH_BR, PH_OUT, PH_THB, PH_UP1, PH_DN1, PH_THC };

__global__ void __launch_bounds__(NWAVES * 64, 2) fwd_kernel(Args args) {
    extern __shared__ __attribute__((aligned(16))) unsigned char lds_raw[];
    LAS unsigned char* lds = (LAS unsigned char*)lds_raw;
    volatile LAS unsigned* MISC = (volatile LAS unsigned*)(lds + MISC_OFF);
    const int tid = threadIdx.x;
    const int G = gridDim.x; const int vcu = blockIdx.x;
    for (int u = tid; u < (LDS_BYTES - MISC_OFF) / 4; u += NWAVES * 64) ((LAS unsigned*)(lds + MISC_OFF))[u] = 0u;
    __syncthreads();
    unsigned* barw = (unsigned*)(wsp(args) + WS_CTL) + CW_BAR;
    XcdBarrier bar = xcd_barrier_post(barw, MISC + 8);
    const int lo = args.ph_lo, hi = args.ph_hi;
#define IN(k) (lo <= (k) && (k) < hi)
#define SEAM(k) do { if ((k) + 1 < hi) xcd_barrier(bar); } while (0)
#pragma clang loop unroll(full)
    for (int l = 0; l < NLAYER_LOOP; ++l) {
        const int pb = l * NPH;
        if (EN_CONV && IN(pb + PH_CONV)) { conv_phase(args, l, lds, vcu, G); SEAM(pb + PH_CONV); }
        if (l == 0 && IN(pb + PH_INIT)) { if (EN_THIN) thin_phase<true, false, true>(args, 0, 0, 0.f, 0, 0, vcu, G); SEAM(pb + PH_INIT); }
#pragma clang loop unroll(full)
        for (int s = 0; s < NSUB_LOOP; ++s) {
            if (IN(pb + (s ? PH_UP1 : PH_UP0))) {
                unsigned char* ws = wsp(args);
                pg8::Gemm g{(const pg8::bf16_t*)(ws + WS_H), (const pg8::bf16_t*)(ws + WS_WT + WT_UP + (size_t)s * 44 * MiB), M, FF2, D}; pg8::StaticOrder S; S.init(M, FF2, G, vcu);
                pg8::EpiSwiglu E{(pg8::bf16_t*)(ws + WS_Z), FF};
                if (EN_GEMM) pg8::gemm_phase<pg8::EpiSwiglu, pg8::StaticOrder, true, true>(lds, g, S, E);
                SEAM(pb + (s ? PH_UP1 : PH_UP0));
            }
            if (IN(pb + (s ? PH_DN1 : PH_DN0))) {
                unsigned char* ws = wsp(args);
                pg8::Gemm g{(const pg8::bf16_t*)(ws + WS_Z), (const pg8::bf16_t*)(ws + WS_WT + WT_DN + (size_t)s * 22 * MiB), M, D, FF}; pg8::StaticOrder S; S.init(M, D, G, vcu);
                pg8::EpiF32 E{(float*)(ws + WS_Y), D};
                if (EN_GEMM) pg8::gemm_phase<pg8::EpiF32, pg8::StaticOrder, true, true>(lds, g, S, E);
                SEAM(pb + (s ? PH_DN1 : PH_DN0));
            }
            if (s == 0) {
                if (IN(pb + PH_THA)) { if (EN_THIN) thin_phase<false, true, true>(args, l, 0, 0.5f, l, 1, vcu, G); SEAM(pb + PH_THA); }
                if (IN(pb + PH_IN)) {
                    unsigned char* ws = wsp(args); float* outb = outp(args);
                    pg8::Gemm g{(const pg8::bf16_t*)(ws + WS_H), (const pg8::bf16_t*)(ws + WS_WT + WT_IN), M, INW, D}; pg8::StaticOrder S; S.init(M, INW, G, vcu);
                    pg8::EpiZ E{(pg8::bf16_t*)(ws + WS_Z), INW, outb + OUT_CK + (size_t)l * 256 * 1024, outb + OUT_CV + (size_t)l * 256 * 1024};
                    if (EN_GEMM) pg8::gemm_phase<pg8::EpiZ, pg8::StaticOrder, true, true>(lds, g, S, E);
                    SEAM(pb + PH_IN);
                }
                if (IN(pb + PH_MIX1)) {
                    for (int sl = vcu; sl < 256; sl += G) {
                        const int nch = sl < 128 ? 1 : 4;
                        for (int k = 0; k < nch; ++k) { const int c = sl < 128 ? sl : (sl - 128) * 4 + k; if (EN_R1) ret_chain(args, l, lds, sl < 128 ? 1 : 0, c >> 4, (c >> 1) & 7, c & 1); }
                    }
                    for (int u = vcu; u < 512; u += G) { const int grp = u >> 8, v = u & 255; if (EN_GM) gmlp_unit(args, l, lds, grp, grp ? v >> 5 : v >> 3, grp ? (v >> 2) & 7 : (v >> 2) & 1, v & 3); }
                    for (int u = vcu; u < 512; u += G) if (EN_AD) attn_dense_unit(args, lds, u >> 4, (u >> 1) & 7, u & 1);
                    for (int u = vcu; u < 512; u += G) if (EN_AN) attn_na_unit(args, l, lds, u >> 6, (u >> 2) & 15, u & 3);
                    SEAM(pb + PH_MIX1);
                }
                if (IN(pb + PH_MIX2)) {
                    for (int u = vcu; u < 1024; u += G) { const int grp = u >> 9, v = u & 511; if (EN_R2) ret_out_unit(args, l, lds, grp, grp ? v >> 6 : v >> 4, grp ? (v >> 3) & 7 : (v >> 1) & 7, grp ? v & 7 : v & 1); }
                    SEAM(pb + PH_MIX2);
                }
                if (IN(pb + PH_BR)) {
                    unsigned char* ws = wsp(args);
                    pg8::StaticOrder S; S.init(M, D, G, vcu);
                    const pg8::bf16_t* Zb = (const pg8::bf16_t*)(ws + WS_Z);
                    { pg8::Gemm g{(const pg8::bf16_t*)(ws + WS_RET), (const pg8::bf16_t*)(ws + WS_WT + WT_BR), M, D, D};
                      pg8::EpiMerge<0> E{Zb + ZC_GA, INW, (float*)(ws + WS_Y), (pg8::bf16_t*)(ws + WS_H), D}; if (EN_GEMM) pg8::gemm_phase<pg8::EpiMerge<0>, pg8::StaticOrder, true, true>(lds, g, S, E); }
                    { pg8::Gemm g{(const pg8::bf16_t*)(ws + WS_GM), (const pg8::bf16_t*)(ws + WS_WT + WT_BG), M, D, 1024};
                      pg8::EpiMerge<1> E{Zb + ZC_GA + 2048, INW, (float*)(ws + WS_Y), (pg8::bf16_t*)(ws + WS_H), D}; if (EN_GEMM) pg8::gemm_phase<pg8::EpiMerge<1>, pg8::StaticOrder, true, true>(lds, g, S, E); }
                    { pg8::Gemm g{(const pg8::bf16_t*)(ws + WS_NA), (const pg8::bf16_t*)(ws + WS_WT + WT_BN), M, D, 1024};
                      pg8::EpiMerge<2> E{Zb + ZC_GA + 4096, INW, (float*)(ws + WS_Y), (pg8::bf16_t*)(ws + WS_H), D}; if (EN_GEMM) pg8::gemm_phase<pg8::EpiMerge<2>, pg8::StaticOrder, true, true>(lds, g, S, E); }
                    SEAM(pb + PH_BR);
                }
                if (IN(pb + PH_OUT)) {
                    unsigned char* ws = wsp(args);
                    pg8::Gemm g{(const pg8::bf16_t*)(ws + WS_H), (const pg8::bf16_t*)(ws + WS_WT + WT_OUT), M, D, D}; pg8::StaticOrder S; S.init(M, D, G, vcu);
                    pg8::EpiF32 E{(float*)(ws + WS_Y), D};
                    if (EN_GEMM) pg8::gemm_phase<pg8::EpiF32, pg8::StaticOrder, true, true>(lds, g, S, E);
                    SEAM(pb + PH_OUT);
                }
                if (IN(pb + PH_THB)) { if (EN_THIN) thin_phase<false, true, true>(args, l, 1, 1.0f, l, 2, vcu, G); SEAM(pb + PH_THB); }
            } else {
                if (IN(pb + PH_THC)) {
                    if (l == 0) { if (EN_THIN) thin_phase<false, true, true>(args, 0, 2, 0.5f, 1, 0, vcu, G); }
                    else        if (EN_THIN) thin_phase<false, true, false>(args, 1, 2, 0.5f, 0, 0, vcu, G);
                    SEAM(pb + PH_THC);
                }
            }
        }
    }
#undef IN
#undef SEAM
}

extern "C" void kernel_launch(void* const* d_in, const int* in_sizes, int n_in, void* d_out, int out_size, void* d_ws, size_t ws_size, hipStream_t stream) {
    static int grid = 0;
    if (grid == 0) {
        if (n_in != N_IN || (size_t)out_size != OUT_TOTAL || ws_size < WS_END) { fprintf(stderr, "kernel_launch: unexpected shapes: n_in %d out %d ws %zu (need %zu); nothing launched\n", n_in, out_size, ws_size, (size_t)WS_END); grid = -1; return; }
        int dev = 0, cus = 0, per_cu = 0;
        if (hipGetDevice(&dev) != hipSuccess || hipDeviceGetAttribute(&cus, hipDeviceAttributeMultiprocessorCount, dev) != hipSuccess) { grid = -1; return; }
        if (hipFuncSetAttribute((const void*)fwd_kernel, hipFuncAttributeMaxDynamicSharedMemorySize, LDS_BYTES) != hipSuccess) { fprintf(stderr, "kernel_launch: hipFuncSetAttribute failed\n"); grid = -1; return; }
        if (hipOccupancyMaxActiveBlocksPerMultiprocessor(&per_cu, (const void*)fwd_kernel, NWAVES * 64, LDS_BYTES) != hipSuccess || per_cu < 1) { fprintf(stderr, "kernel_launch: occupancy query reports %d workgroups per CU\n", per_cu); }
        (void)hipGetLastError();
        grid = cus;
        if (per_cu < 1) grid = -1;
    }
    if (grid < 0) return;
    if (hipMemsetAsync((char*)d_ws + WS_CTL, 0, CTL_ZERO_BYTES, stream) != hipSuccess) return;
    Args a{};
    for (int i = 0; i < N_IN; ++i) a.in[i] = (const float*)d_in[i];
    a.out = (float*)d_out; a.ws = (unsigned char*)d_ws;
#if MK_SPLIT
    for (int p = 0; p < 2 * NPH; ++p) { if (p == NPH + PH_INIT) continue; a.ph_lo = p; a.ph_hi = p + 1; hipLaunchKernelGGL(fwd_kernel, dim3(grid), dim3(NWAVES * 64), LDS_BYTES, stream, a); }
#else
    a.ph_lo = 0; a.ph_hi = 2 * NPH;
    hipLaunchKernelGGL(fwd_kernel, dim3(grid), dim3(NWAVES * 64), LDS_BYTES, stream, a);
#endif
    const hipError_t le = hipPeekAtLastError();
    if (le != hipSuccess) fprintf(stderr, "kernel_launch: launch failed: %s\n", hipGetErrorName(le));
}
```

```cpp
#include <hip/hip_runtime.h>
#include <cstdio>
#include <cstdint>
namespace pg8 {
#define PG8_LAS __attribute__((address_space(3)))
typedef unsigned short bf16_t;
typedef short bf16x8 __attribute__((ext_vector_type(8)));
typedef float f32x4 __attribute__((ext_vector_type(4)));
typedef unsigned u32x4 __attribute__((ext_vector_type(4)));
constexpr int BM = 256, BK = 64, HALF = 128, HTB = HALF * BK * 2  , STAGE_BYTES = 8 * HTB, NXCD = 8, WGM = 8;

__host__ __device__ __forceinline__ int lds_byte(int r, int c) { const int st = (r >> 4) * 2 + (c >> 5), rr = r & 15, cc = c & 31, ob = rr * 64 + cc * 2; return st * 1024 + (ob ^ (((ob >> 9) & 1) << 5)); }
__host__ __device__ __forceinline__ void stage_rc(int b, int& R, int& C) { const int st = b / 1024, sb = b % 1024, swz = sb ^ (((sb >> 9) & 1) << 5); R = (st >> 1) * 16 + swz / 64; C = (st & 1) * 32 + (swz % 64) / 2; }
__host__ __device__ __forceinline__ int perm32(int rho) { const int n = rho >> 4, i = rho & 15; return 8 * (i >> 2) + 4 * n + (i & 3); }

struct Unit { int pm, pn; };
struct Gemm { const bf16_t* A; const bf16_t* Bt; int M, N, K; };

struct StaticOrder {
    int nM, nN, nwg, G, c;
    __host__ __device__ void init(int M, int N, int G_, int c_) { nM = M / BM; nN = N / BM; nwg = nM * nN; G = G_; c = c_; }
    __host__ __device__ bool next(int i, Unit& u) const {
        const long L = (long)i * G + c; if (L >= nwg) return false;
        int wgid = (int)L; { const int q = nwg / NXCD, r = nwg % NXCD, xcd = wgid % NXCD, off = wgid / NXCD; wgid = (xcd < r ? xcd * (q + 1) : r * (q + 1) + (xcd - r) * q) + off; }
        const int nig = WGM * nN, gid = wgid / nig, fm = gid * WGM, gsz = (nM - fm) < WGM ? (nM - fm) : WGM;
        u.pm = fm + ((wgid % nig) % gsz); u.pn = (wgid % nig) / gsz; return true;
    }
    __device__ __forceinline__ void a_ready(const Unit&) const {}
    __device__ __forceinline__ void done(const Unit&) const {}
};

__device__ __forceinline__ unsigned cvt_pk_bf16(float lo, float hi) { unsigned r; asm volatile("v_cvt_pk_bf16_f32 %0, %1, %2" : "=v"(r) : "v"(lo), "v"(hi)); return r; }
typedef float f32x2 __attribute__((ext_vector_type(2)));
__device__ __forceinline__ float sigm_f(float a) { return __builtin_amdgcn_rcpf(1.0f + __expf(-a)); }
__device__ __forceinline__ float silu_f(float a) { return a * sigm_f(a); }
__device__ __forceinline__ float bf_lo(unsigned w) { return __uint_as_float(w << 16); }
__device__ __forceinline__ float bf_hi(unsigned w) { return __uint_as_float(w & 0xffff0000u); }
struct EpiSwiglu {
    static constexpr bool PERM = true, AFTER_DRAIN = false;
    bf16_t* O; int ldc;
    __device__ __forceinline__ void operator()(const f32x4 (&acc)[2][2][4][2], const Unit& u, int wr, int wc, int fr, int fq) const {
        const int row0 = u.pm * BM + wr * 64 + fr, col0 = u.pn * HALF + wc * 32 + 8 * fq;
#pragma unroll
        for (int ai = 0; ai < 2; ++ai)
#pragma unroll
            for (int m = 0; m < 4; ++m) { bf16_t* rowp = O + (size_t)(row0 + ai * HALF + m * 16) * ldc + col0;
                const f32x4 a0 = acc[ai][0][m][0], a1 = acc[ai][0][m][1], b0 = acc[ai][1][m][0], b1 = acc[ai][1][m][1];
                u32x4 w; w.x = cvt_pk_bf16(silu_f(a0[0]) * b0[0], silu_f(a0[1]) * b0[1]); w.y = cvt_pk_bf16(silu_f(a0[2]) * b0[2], silu_f(a0[3]) * b0[3]);
                w.z = cvt_pk_bf16(silu_f(a1[0]) * b1[0], silu_f(a1[1]) * b1[1]); w.w = cvt_pk_bf16(silu_f(a1[2]) * b1[2], silu_f(a1[3]) * b1[3]);
                *(u32x4*)rowp = w; }
    }
};
struct EpiBf16 {
    static constexpr bool PERM = true, AFTER_DRAIN = false;
    bf16_t* O; int ldc;
    __device__ __forceinline__ void operator()(const f32x4 (&acc)[2][2][4][2], const Unit& u, int wr, int wc, int fr, int fq) const {
        const int row0 = u.pm * BM + wr * 64 + fr, col0 = u.pn * BM + wc * 32 + 8 * fq;
#pragma unroll
        for (int ai = 0; ai < 2; ++ai)
#pragma unroll
            for (int m = 0; m < 4; ++m) { bf16_t* rowp = O + (size_t)(row0 + ai * HALF + m * 16) * ldc + col0;
#pragma unroll
                for (int bj = 0; bj < 2; ++bj) { const f32x4 v0 = acc[ai][bj][m][0], v1 = acc[ai][bj][m][1];
                    u32x4 w; w.x = cvt_pk_bf16(v0[0], v0[1]); w.y = cvt_pk_bf16(v0[2], v0[3]); w.z = cvt_pk_bf16(v1[0], v1[1]); w.w = cvt_pk_bf16(v1[2], v1[3]);
                    *(u32x4*)(rowp + bj * HALF) = w; } }
    }
};
struct EpiZ {
    static constexpr bool PERM = true, AFTER_DRAIN = false;
    bf16_t* Z; int ldc; float* ck; float* cv;
    __device__ __forceinline__ void operator()(const f32x4 (&acc)[2][2][4][2], const Unit& u, int wr, int wc, int fr, int fq) const {
        const int row0 = u.pm * BM + wr * 64 + fr, col0 = u.pn * BM + wc * 32 + 8 * fq;
        const bool isk = (u.pm < 32) && (u.pn >= 36) && (u.pn < 40), isv = (u.pm < 32) && (u.pn >= 40) && (u.pn < 44);
        float* cbase = isk ? ck : cv; const int csub = isk ? 9216 : 10240;
#pragma unroll
        for (int ai = 0; ai < 2; ++ai)
#pragma unroll
            for (int m = 0; m < 4; ++m) { const int r = row0 + ai * HALF + m * 16; bf16_t* rowp = Z + (size_t)r * ldc + col0;
#pragma unroll
                for (int bj = 0; bj < 2; ++bj) { const f32x4 v0 = acc[ai][bj][m][0], v1 = acc[ai][bj][m][1];
                    u32x4 w; w.x = cvt_pk_bf16(v0[0], v0[1]); w.y = cvt_pk_bf16(v0[2], v0[3]); w.z = cvt_pk_bf16(v1[0], v1[1]); w.w = cvt_pk_bf16(v1[2], v1[3]);
                    *(u32x4*)(rowp + bj * HALF) = w;
                    if (isk || isv) { float* dst = cbase + ((size_t)u.pm * 2 * 256 + (size_t)(r & 255)) * 1024 + (col0 + bj * HALF - csub);
                        *(f32x4*)dst = v0; *(f32x4*)(dst + 4) = v1; } } }
    }
};
template <int STAGE> struct EpiMerge {
    static constexpr bool PERM = true, AFTER_DRAIN = false;
    const bf16_t* Zg; int ldz; bf16_t* MB; int ldm;
    __device__ __forceinline__ void operator()(const f32x4 (&acc)[2][2][4][2], const Unit& u, int wr, int wc, int fr, int fq) const {
        const int row0 = u.pm * BM + wr * 64 + fr, col0 = u.pn * BM + wc * 32 + 8 * fq;
#pragma unroll
        for (int ai = 0; ai < 2; ++ai)
#pragma unroll
            for (int m = 0; m < 4; ++m) { const int r = row0 + ai * HALF + m * 16;
#pragma unroll
                for (int bj = 0; bj < 2; ++bj) { const int c = col0 + bj * HALF;
                    const u32x4 gw = *(const u32x4*)(Zg + (size_t)r * ldz + c);
                    f32x4 v0 = acc[ai][bj][m][0], v1 = acc[ai][bj][m][1];
                    v0[0] *= sigm_f(bf_lo(gw.x)); v0[1] *= sigm_f(bf_hi(gw.x)); v0[2] *= sigm_f(bf_lo(gw.y)); v0[3] *= sigm_f(bf_hi(gw.y));
                    v1[0] *= sigm_f(bf_lo(gw.z)); v1[1] *= sigm_f(bf_hi(gw.z)); v1[2] *= sigm_f(bf_lo(gw.w)); v1[3] *= sigm_f(bf_hi(gw.w));
                    bf16_t* mp = MB + (size_t)r * ldm + c;
                    if (STAGE > 0) { const u32x4 pw = *(const u32x4*)mp;
                        v0[0] += bf_lo(pw.x); v0[1] += bf_hi(pw.x); v0[2] += bf_lo(pw.y); v0[3] += bf_hi(pw.y); v1[0] += bf_lo(pw.z); v1[1] += bf_hi(pw.z); v1[2] += bf_lo(pw.w); v1[3] += bf_hi(pw.w); }
                    u32x4 w; w.x = cvt_pk_bf16(v0[0], v0[1]); w.y = cvt_pk_bf16(v0[2], v0[3]); w.z = cvt_pk_bf16(v1[0], v1[1]); w.w = cvt_pk_bf16(v1[2], v1[3]);
                    *(u32x4*)mp = w; } }
    }
};

template <class Epi, class Sched, bool ALIGN_EPI = false, bool SP2 = false>
__device__ __forceinline__ void gemm_phase(PG8_LAS unsigned char* lds, const Gemm g, const Sched& S, const Epi& E) {
    const int tid = threadIdx.x, wid = __builtin_amdgcn_readfirstlane(tid >> 6), lane = tid & 63, wr = wid >> 2, wc = wid & 3, fr = lane & 15, fq = lane >> 4;
    const int K = g.K, nt = K / BK;
    unsigned voffA[2], voffB[2];
#pragma unroll
    for (int i = 0; i < 2; ++i) { int R, C; stage_rc(tid * 16 + i * 8192, R, C); const int Rb = Epi::PERM ? ((R & ~31) + perm32(R & 31)) : R;
        voffA[i] = (unsigned)(R * K + C) * 2u; voffB[i] = (unsigned)(Rb * K + C) * 2u; }
    const size_t kstep = (size_t)(BK * 2);
    const size_t hstep = (size_t)HALF * K * 2;
    const size_t tstep = 2 * hstep;
    const unsigned ldsw = (unsigned)wid * 1024u;
    const int aoff = lds_byte(wr * 64 + fr, fq * 8), boff = lds_byte(wc * 32 + fr, fq * 8);
#define PG8_SA(b, h) (((b) * 2 + (h)) * HTB)
#define PG8_SB(b, h) ((4 + (b) * 2 + (h)) * HTB)
#define PG8_STAGE(bufoff, gbase, voff) do { _Pragma("unroll") for (int _i = 0; _i < 2; ++_i) \
        __builtin_amdgcn_global_load_lds((const unsigned*)((const char*)(gbase) + (voff)[_i]), (PG8_LAS unsigned*)(lds + (bufoff) + ldsw + _i * 8192), 16, 0, 0); } while (0)
#define PG8_LDA(dst, b, h) do { _Pragma("unroll") for (int m = 0; m < 4; ++m) _Pragma("unroll") for (int k = 0; k < 2; ++k) dst[m][k] = *(const PG8_LAS bf16x8*)(lds + PG8_SA(b, h) + aoff + m * 2048 + k * 1024); } while (0)
#define PG8_LDB(dst, b, h) do { _Pragma("unroll") for (int n = 0; n < 2; ++n) _Pragma("unroll") for (int k = 0; k < 2; ++k) dst[n][k] = *(const PG8_LAS bf16x8*)(lds + PG8_SB(b, h) + boff + n * 2048 + k * 1024); } while (0)
#define PG8_MMA(ai, bj, At, Bt) do { __builtin_amdgcn_s_setprio(1); _Pragma("unroll") for (int m = 0; m < 4; ++m) _Pragma("unroll") for (int n = 0; n < 2; ++n) _Pragma("unroll") for (int k = 0; k < 2; ++k) \
        acc[ai][bj][m][n] = __builtin_amdgcn_mfma_f32_16x16x32_bf16(Bt[n][k], At[m][k], acc[ai][bj][m][n], 0, 0, 0); __builtin_amdgcn_s_setprio(0); } while (0)
#define PG8_WAIT_V(n) asm volatile("s_waitcnt vmcnt(" #n ")" ::: "memory")
#define PG8_WAIT_L(n) asm volatile("s_waitcnt lgkmcnt(" #n ")" ::: "memory")
#define PG8_BAR __builtin_amdgcn_s_barrier()
#define PG8_SCHED __builtin_amdgcn_sched_barrier(0)
    Unit cur, nxt; int ui = 0;
    if (!S.next(0, cur)) return;
    f32x4 acc[2][2][4][2];
#pragma unroll
    for (int a = 0; a < 2; ++a)
#pragma unroll
        for (int b = 0; b < 2; ++b)
#pragma unroll
            for (int m = 0; m < 4; ++m)
#pragma unroll
                for (int n = 0; n < 2; ++n) acc[a][b][m][n] = (f32x4){0.f, 0.f, 0.f, 0.f};
    bf16x8 At[4][2], B0[2][2], B1[2][2];
    const char* cA = (const char*)g.A + (size_t)cur.pm * tstep; const char* cB = (const char*)g.Bt + (size_t)cur.pn * tstep;
    S.a_ready(cur);
    if constexpr (SP2) {
        PG8_STAGE(PG8_SB(0, 0), cB, voffB); PG8_STAGE(PG8_SB(0, 1), cB + hstep, voffB); PG8_STAGE(PG8_SA(0, 0), cA, voffA); PG8_STAGE(PG8_SA(0, 1), cA + hstep, voffA);
        if (wr == 1) PG8_BAR;
        PG8_WAIT_V(2); PG8_BAR;
        PG8_STAGE(PG8_SB(1, 0), cB + kstep, voffB); PG8_STAGE(PG8_SA(1, 0), cA + kstep, voffA); PG8_STAGE(PG8_SB(1, 1), cB + hstep + kstep, voffB);
        PG8_WAIT_V(6); PG8_BAR;
    } else {
        PG8_STAGE(PG8_SB(0, 0), cB, voffB); PG8_STAGE(PG8_SA(0, 0), cA, voffA); PG8_STAGE(PG8_SB(0, 1), cB + hstep, voffB); PG8_STAGE(PG8_SA(0, 1), cA + hstep, voffA);
        if (wr == 1) PG8_BAR;
        PG8_WAIT_V(4); PG8_BAR;
        PG8_STAGE(PG8_SB(1, 0), cB + kstep, voffB); PG8_STAGE(PG8_SA(1, 0), cA + kstep, voffA); PG8_STAGE(PG8_SB(1, 1), cB + hstep + kstep, voffB);
        PG8_WAIT_V(6); PG8_BAR;
    }
    for (;;) {
        const bool has_next = S.next(ui + 1, nxt);
        const char* nA = has_next ? (const char*)g.A + (size_t)nxt.pm * tstep : cA; const char* nB = has_next ? (const char*)g.Bt + (size_t)nxt.pn * tstep : cB;
        for (int t = 0; t < nt; t += 2) {
            const bool last = (t == nt - 2);
            const char* a1 = cA + (size_t)(t + 1) * kstep;
            const char* a2 = last ? nA : cA + (size_t)(t + 2) * kstep; const char* b2 = last ? nB : cB + (size_t)(t + 2) * kstep;
            const char* a3 = a2 + kstep; const char* b3 = b2 + kstep;
            if (last && has_next) S.a_ready(nxt);
            if constexpr (SP2) {
            PG8_LDB(B0, 0, 0); PG8_LDB(B1, 0, 1); PG8_SCHED; PG8_LDA(At, 0, 0); PG8_STAGE(PG8_SA(1, 1), a1 + hstep, voffA);
            PG8_WAIT_V(8); PG8_WAIT_L(0); PG8_BAR; PG8_MMA(0, 0, At, B0); PG8_MMA(0, 1, At, B1); PG8_BAR; PG8_SCHED;
            PG8_LDA(At, 0, 1); PG8_STAGE(PG8_SB(0, 0), b2, voffB); PG8_STAGE(PG8_SB(0, 1), b2 + hstep, voffB); PG8_STAGE(PG8_SA(0, 0), a2, voffA);
            PG8_WAIT_V(8); PG8_WAIT_L(0); PG8_BAR; PG8_MMA(1, 0, At, B0); PG8_MMA(1, 1, At, B1); PG8_BAR; PG8_SCHED;
            PG8_LDB(B0, 1, 0); PG8_LDB(B1, 1, 1); PG8_SCHED; PG8_LDA(At, 1, 0); PG8_STAGE(PG8_SA(0, 1), a2 + hstep, voffA);
            PG8_WAIT_V(8); PG8_WAIT_L(0); PG8_BAR; PG8_MMA(0, 0, At, B0); PG8_MMA(0, 1, At, B1); PG8_BAR; PG8_SCHED;
            PG8_LDA(At, 1, 1); PG8_STAGE(PG8_SB(1, 0), b3, voffB); PG8_STAGE(PG8_SB(1, 1), b3 + hstep, voffB); PG8_STAGE(PG8_SA(1, 0), a3, voffA);
            PG8_WAIT_V(8); PG8_WAIT_L(0); PG8_BAR; PG8_MMA(1, 0, At, B0); PG8_MMA(1, 1, At, B1); PG8_BAR; PG8_SCHED;
            } else {
            PG8_LDB(B0, 0, 0); PG8_SCHED; PG8_LDA(At, 0, 0); PG8_STAGE(PG8_SA(1, 1), a1 + hstep, voffA);
            PG8_WAIT_L(8); PG8_BAR; PG8_WAIT_L(0); PG8_MMA(0, 0, At, B0); PG8_BAR; PG8_SCHED;
            PG8_LDB(B1, 0, 1); PG8_STAGE(PG8_SB(0, 0), b2, voffB);
            PG8_BAR; PG8_WAIT_L(0); PG8_MMA(0, 1, At, B1); PG8_BAR;
            PG8_LDA(At, 0, 1); PG8_STAGE(PG8_SA(0, 0), a2, voffA);
            PG8_BAR; PG8_WAIT_L(0); PG8_MMA(1, 0, At, B0); PG8_BAR; PG8_SCHED;
            PG8_STAGE(PG8_SB(0, 1), b2 + hstep, voffB);
            PG8_WAIT_V(6); PG8_BAR; PG8_MMA(1, 1, At, B1); PG8_BAR;
            PG8_LDB(B0, 1, 0); PG8_SCHED; PG8_LDA(At, 1, 0); PG8_STAGE(PG8_SA(0, 1), a2 + hstep, voffA);
            PG8_WAIT_L(8); PG8_BAR; PG8_WAIT_L(0); PG8_MMA(0, 0, At, B0); PG8_BAR; PG8_SCHED;
            PG8_LDB(B1, 1, 1); PG8_STAGE(PG8_SB(1, 0), b3, voffB);
            PG8_BAR; PG8_WAIT_L(0); PG8_MMA(0, 1, At, B1); PG8_BAR;
            PG8_LDA(At, 1, 1); PG8_STAGE(PG8_SA(1, 0), a3, voffA);
            PG8_BAR; PG8_WAIT_L(0); PG8_MMA(1, 0, At, B0); PG8_BAR; PG8_SCHED;
            PG8_STAGE(PG8_SB(1, 1), b3 + hstep, voffB);
            PG8_WAIT_V(6); PG8_BAR; PG8_MMA(1, 1, At, B1); PG8_BAR;
            }
        }
        if constexpr (ALIGN_EPI) { if (wr == 0) PG8_BAR; }
        if constexpr (!Epi::AFTER_DRAIN) { E(acc, cur, wr, wc, fr, fq); S.done(cur); }
        if (!has_next) break;
#pragma unroll
        for (int a = 0; a < 2; ++a)
#pragma unroll
            for (int b = 0; b < 2; ++b)
#pragma unroll
                for (int m = 0; m < 4; ++m)
#pragma unroll
                    for (int n = 0; n < 2; ++n) acc[a][b][m][n] = (f32x4){0.f, 0.f, 0.f, 0.f};
        cur = nxt; cA = nA; cB = nB; ++ui;
        if constexpr (ALIGN_EPI) { if (wr == 1) PG8_BAR; }
    }
    PG8_WAIT_V(0);
    if constexpr (!ALIGN_EPI) { if (wr == 0) PG8_BAR; }
    PG8_BAR;
    if constexpr (Epi::AFTER_DRAIN) { E.fused(acc, cur, wr, wc, fr, fq, lds, wid, lane); S.done(cur); }
#undef PG8_SA
#undef PG8_SB
#undef PG8_STAGE
#undef PG8_LDA
#undef PG8_LDB
#undef PG8_MMA
#undef PG8_WAIT_V
#undef PG8_WAIT_L
#undef PG8_BAR
#undef PG8_SCHED
}
}

constexpr int NWAVES = 8;
constexpr int D = 2048, FF = 5632, FF2 = 2 * FF, INW = 17408, NMODV = 9, NMODW = 18432;
constexpr int MC = 8192, ML = 8192, M = MC + ML;
constexpr int ZC_RQ = 0, ZC_RK = 1024, ZC_RV = 2048, ZC_RG = 4096, ZC_GU = 6144, ZC_GV = 7168, ZC_NQ = 8192, ZC_NK = 9216, ZC_NV = 10240, ZC_GA = 11264;
constexpr float NORM_EPS = 1e-6f;
constexpr float LOG2E = 1.4426950408889634f;
enum { I_XP = 0, I_XS, I_CK, I_CV, I_SR, I_C, I_CCTX, I_WADA, I_BADA, I_NPRE, I_NPOST, I_FWIN, I_FWOUT, I_WIN, I_RDL, I_GMN, I_GMWS, I_GMBS, I_RPB, I_WBR, I_WBG, I_WBN, I_WOUT, N_IN };
constexpr size_t OUT_X = 0, OUT_CK = 33554432, OUT_CV = 50331648, OUT_ST = 67108864, OUT_TOTAL = 100663296;
constexpr size_t MiB = 1u << 20;
constexpr size_t WS_CTL = 0, CTL_ZERO_BYTES = 1 * MiB;
constexpr size_t WS_ROT = 1 * MiB;
constexpr size_t WS_MOD = 2 * MiB;
constexpr size_t WS_WT = 8 * MiB;
constexpr size_t WT_UP = 0, WT_DN = 88 * MiB, WT_IN = 132 * MiB, WT_BR = 200 * MiB, WT_BG = 208 * MiB, WT_BN = 212 * MiB, WT_OUT = 216 * MiB;
constexpr size_t WS_Z = 232 * MiB;
constexpr size_t WS_Y = 776 * MiB;
constexpr size_t WS_H = 904 * MiB;
constexpr size_t WS_RET = 968 * MiB, WS_GM = 1032 * MiB, WS_NA = 1064 * MiB, WS_END = 1096 * MiB;
constexpr int CW_BAR = 4096;
constexpr int LDS_BYTES = 151552;
constexpr int MISC_OFF = 150528;

#define GAS __attribute__((address_space(1)))
#define LAS __attribute__((address_space(3)))
typedef unsigned short bf16;
typedef unsigned v4u __attribute__((ext_vector_type(4)));
typedef unsigned v2u __attribute__((ext_vector_type(2)));
typedef float f32x4 __attribute__((ext_vector_type(4)));
typedef float f32x2 __attribute__((ext_vector_type(2)));
typedef short bf16x8 __attribute__((ext_vector_type(8)));
typedef short bf16x4 __attribute__((ext_vector_type(4)));
typedef GAS unsigned gu32;
#define LDS_WAIT() asm volatile("s_waitcnt lgkmcnt(0)" ::: "memory")
#define VM_WAIT() asm volatile("s_waitcnt vmcnt(0)" ::: "memory")
__device__ __forceinline__ unsigned pk2(float lo, float hi) { return pg8::cvt_pk_bf16(lo, hi); }
__device__ __forceinline__ float bflo(unsigned w) { return __uint_as_float(w << 16); }
__device__ __forceinline__ float bfhi(unsigned w) { return __uint_as_float(w & 0xffff0000u); }
__device__ __forceinline__ float wave_sum(float v) {
#pragma unroll
    for (int o = 1; o < 64; o <<= 1) v += __shfl_xor(v, o);
    return v;
}
#define MFMA16(a, b, c) __builtin_amdgcn_mfma_f32_16x16x32_bf16((a), (b), (c), 0, 0, 0)
#define TR16(p) __builtin_amdgcn_ds_read_tr16_b64_v4i16((LAS bf16x4*)(p))
__device__ __forceinline__ bf16x8 frag_rk(const LAS bf16* base, int pitch, int row0, int k0, int lane) {
    return *(const LAS bf16x8*)(base + (row0 + (lane & 15)) * pitch + k0 + 8 * (lane >> 4));
}
__device__ __forceinline__ bf16x8 frag_ck2(const LAS bf16* base, int pitch, int rowA, int rowB, int c0, int lane) {
    const int off = (4 * (lane >> 4) + ((lane & 15) >> 2)) * pitch + c0 + 4 * (lane & 3);
    const bf16x4 lo = TR16(base + rowA * pitch + off), hi = TR16(base + rowB * pitch + off);
    return __builtin_shufflevector(lo, hi, 0, 1, 2, 3, 4, 5, 6, 7);
}
__device__ __forceinline__ bf16x8 frag_ck(const LAS bf16* base, int pitch, int k0, int c0, int lane) {
    const LAS bf16* p = base + (k0 + 8 * (lane >> 4) + ((lane & 15) >> 2)) * pitch + c0 + 4 * (lane & 3);
    const bf16x4 lo = TR16(p), hi = TR16(p + 4 * pitch);
    return __builtin_shufflevector(lo, hi, 0, 1, 2, 3, 4, 5, 6, 7);
}
#define RLX_AGENT __ATOMIC_RELAXED, __HIP_MEMORY_SCOPE_AGENT
#define XB_TMO      128
#define XB_XCNT(j)  (256  + 64 * (j))
#define XB_XSUB(j)  (1280 + 64 * (j))
#define XB_XGEN(j)  (2304 + 64 * (j))
#define XB_TOP      3328
#define XB_TOPGEN   3392
#define XCD_BAR_WORDS 3456
#define XB_SPIN_CAP (1u << 18)

__device__ __forceinline__ unsigned xb_ld(unsigned* p)              { return __hip_atomic_load(p, __ATOMIC_RELAXED, __HIP_MEMORY_SCOPE_AGENT); }
__device__ __forceinline__ unsigned xb_add(unsigned* p, unsigned v) { return __hip_atomic_fetch_add(p, v, __ATOMIC_RELAXED, __HIP_MEMORY_SCOPE_AGENT); }
__device__ __forceinline__ unsigned xb_xcc_id() { return (unsigned)__builtin_amdgcn_s_getreg((3 << 11) | 20) & 0xFu; }
#define XB_SPIN(cond, bar) do { unsigned _sp = 0; while (cond) { __builtin_amdgcn_s_sleep(1); \
    if ((++_sp & 255u) == 0u) { if (xb_ld(&(bar)[XB_TMO])) break; if (_sp > XB_SPIN_CAP) { atomicAdd(&(bar)[XB_TMO], 1u); break; } } } } while (0)

struct XcdBarrier {
    unsigned* bar; unsigned x;
    volatile LAS unsigned* st;
};

__device__ __forceinline__ XcdBarrier xcd_barrier_post(unsigned* bar, volatile LAS unsigned* st) {
    XcdBarrier b; b.bar = bar; b.x = xb_xcc_id(); b.st = st;
    if (threadIdx.x == 0) (void)xb_add(&bar[XB_XCNT(b.x)], 1u);
    return b;
}
__device__ __forceinline__ void xcd_barrier_complete(unsigned* bar, unsigned x, unsigned& nloc, unsigned& nx) {
    const unsigned G = gridDim.x * gridDim.y * gridDim.z;
    unsigned sum, cnt, mine, sp = 0u;
    for (;;) {
        sum = 0u; cnt = 0u; mine = 0u;
#pragma unroll
        for (unsigned j = 0; j < 16; ++j) { const unsigned c = xb_ld(&bar[XB_XCNT(j)]); sum += c; cnt += (c > 0u) ? 1u : 0u; mine = (j == x) ? c : mine; }
        if (sum == G) break;
        __builtin_amdgcn_s_sleep(1);
        if ((++sp & 255u) == 0u) { if (xb_ld(&bar[XB_TMO])) break; if (sp > XB_SPIN_CAP) { atomicAdd(&bar[XB_TMO], 1u); break; } }
    }
    nloc = mine > 0u ? mine : 1u; nx = cnt > 0u ? cnt : 1u;
}

__device__ __forceinline__ void xcd_barrier(const XcdBarrier& b) {
    asm volatile("s_waitcnt vmcnt(0)" ::: "memory");
    __syncthreads();
    if (threadIdx.x == 0) {
        unsigned* bar = b.bar;
        __builtin_amdgcn_s_waitcnt(0);
        unsigned nloc = b.st[0], nx = b.st[1];
        if (nloc == 0u) { xcd_barrier_complete(bar, b.x, nloc, nx); b.st[0] = nloc; b.st[1] = nx; }
        const unsigned old = xb_add(&bar[XB_XSUB(b.x)], 1u);
        const unsigned gen = old / nloc;
        if (old + 1u == (gen + 1u) * nloc) {
            __builtin_amdgcn_fence(__ATOMIC_RELEASE, "agent");
            asm volatile("s_waitcnt vmcnt(0)" ::: "memory");
            const unsigned og = xb_add(&bar[XB_TOP], 1u);
            const unsigned tg = og / nx;
            if (og + 1u == (tg + 1u) * nx) xb_add(&bar[XB_TOPGEN], 1u);
            else XB_SPIN(xb_ld(&bar[XB_TOPGEN]) == tg, bar);
            __builtin_amdgcn_fence(__ATOMIC_ACQUIRE, "agent");
            xb_add(&bar[XB_XGEN(b.x)], 1u);
            asm volatile("s_waitcnt vmcnt(0)" ::: "memory");
        } else {
            XB_SPIN(xb_ld(&bar[XB_XGEN(b.x)]) == gen, bar);
            __builtin_amdgcn_fence(__ATOMIC_ACQUIRE, "agent");
            asm volatile("s_waitcnt vmcnt(0)" ::: "memory");
        }
    }
    __syncthreads();
}

struct Args { const float* in[N_IN]; float* out; unsigned char* ws; int ph_lo, ph_hi; };
__device__ __forceinline__ const float* inp(int i) { const float* const __attribute__((address_space(4)))* kp = (const float* const __attribute__((address_space(4)))*)__builtin_amdgcn_kernarg_segment_ptr(); asm volatile("" : "+s"(kp)); return kp[i]; }

__device__ __forceinline__ unsigned char* wsp(const Args& a) { unsigned char* p = a.ws; asm volatile("" : "+s"(p)); return p; }
__device__ __forceinline__ float* outp(const Args& a) { float* p = a.out; asm volatile("" : "+s"(p)); return p; }
__device__ __forceinline__ int up_destrow(int n) { const int half = n >= FF ? 1 : 0; const int j = n - half * FF; return (j >> 7) * 256 + half * 128 + (j & 127); }
template <bool SWI> __device__ __forceinline__ void transpose_item(const float* __restrict__ W, int K, int N, bf16* __restrict__ WT, LAS float* scr, int item, int lane) {
    const int nblk = N / 64, kb = item / nblk, nb = item - kb * nblk, k0 = 64 * kb, n0 = 64 * nb;
    const int kr = lane >> 4, q = lane & 15;
    const float* src = W + (size_t)(k0 + kr) * N + n0 + 4 * q;
    f32x4 v[16];
#pragma unroll
    for (int i = 0; i < 16; ++i) v[i] = *(const f32x4*)(src + (size_t)(4 * i) * N);
#pragma unroll
    for (int i = 0; i < 16; ++i) { const int k = 4 * i + kr; *(LAS f32x4*)(scr + k * 64 + 4 * (q ^ ((k >> 3) & 7))) = v[i]; }
    LDS_WAIT(); asm volatile("" ::: "memory");
    const int r0 = SWI ? up_destrow(n0) : n0;
    const int c = lane & 7;
#pragma unroll
    for (int j = 0; j < 8; ++j) { const int n = (lane >> 3) + 8 * j; const LAS float* s = scr + (8 * c) * 64 + 4 * ((n >> 2) ^ c) + (n & 3);
        v4u o; o.x = pk2(s[0 * 64], s[1 * 64]); o.y = pk2(s[2 * 64], s[3 * 64]); o.z = pk2(s[4 * 64], s[5 * 64]); o.w = pk2(s[6 * 64], s[7 * 64]);
        *(v4u*)(WT + (size_t)(r0 + n) * K + k0 + 8 * c) = o; }
    LDS_WAIT(); asm volatile("" ::: "memory");
}
__device__ __forceinline__ void conv_phase(const Args& a, const int l, LAS unsigned char* lds, const int vcu, const int G) {
    int tid = threadIdx.x; asm volatile("" : "+v"(tid)); const int lane = tid & 63, wave = __builtin_amdgcn_readfirstlane(tid >> 6);
    unsigned char* ws = wsp(a);
    __syncthreads();
    if (l == 0) {
        { const int gt = vcu * 512 + tid; if (gt < 64 * 32) { const int pos = gt >> 5, f = gt & 31; const float inv = powf(10000.0f, -(float)(2 * f) / 64.0f); const float ang = (float)pos * inv;
            float s, c; sincosf(ang, &s, &c); ((f32x2*)(ws + WS_ROT))[gt] = (f32x2){c, s}; } }
        LAS float* sc = (LAS float*)lds;
        LAS float* red = (LAS float*)(lds + 73728);
        for (int idx = tid; idx < NMODV * D; idx += 512) { const int v = idx >> 11, k = idx & 2047; const float x = (v == 0) ? inp(I_CCTX)[k] : inp(I_C)[(v - 1) * D + k]; sc[idx] = x / (1.0f + expf(-x)); }
        __syncthreads();
        float* MOD = (float*)(ws + WS_MOD);
        const int half = lane >> 5, ln = lane & 31;
        for (int u = vcu; u < 288; u += G) {
            const int la = u / 144, n0 = (u - la * 144) * 128;
            const float* W = inp(I_WADA) + (size_t)la * D * NMODW + n0 + 4 * ln;
            f32x4 acc[NMODV];
#pragma unroll
            for (int v = 0; v < NMODV; ++v) acc[v] = (f32x4){0.f, 0.f, 0.f, 0.f};
#pragma unroll 8
            for (int kk = 0; kk < 128; ++kk) { const int k = wave * 256 + 2 * kk + half; const f32x4 w = *(const f32x4*)(W + (size_t)k * NMODW);
#pragma unroll
                for (int v = 0; v < NMODV; ++v) { const float s = sc[v * D + k]; acc[v] += w * s; } }
#pragma unroll
            for (int v = 0; v < NMODV; ++v) {
#pragma unroll
                for (int j = 0; j < 4; ++j) acc[v][j] += __shfl_xor(acc[v][j], 32);
                if (half == 0) *(LAS f32x4*)(red + (wave * NMODV + v) * 128 + 4 * ln) = acc[v]; }
            __syncthreads();
            for (int o = tid; o < NMODV * 128; o += 512) { const int v = o >> 7, n = o & 127; float s = 0.f;
#pragma unroll
                for (int w = 0; w < 8; ++w) s += red[(w * NMODV + v) * 128 + n];
                MOD[(size_t)(la * NMODV + v) * NMODW + n0 + n] = s + inp(I_BADA)[la * NMODW + n0 + n]; }
            __syncthreads();
        }
    }
    LAS float* scr = (LAS float*)(lds + wave * 16384);
    const int gw = vcu * NWAVES + wave, NGW = G * NWAVES;
    constexpr int I_UP = 32 * 176, I_DN = 88 * 32, I_INW = 32 * 272, I_BRW = 32 * 32, I_BGW = 16 * 32;
    constexpr int NITEMS = 2 * I_UP + 2 * I_DN + I_INW + 2 * I_BRW + 2 * I_BGW;
    bf16* WT = (bf16*)(ws + WS_WT);
    for (int it = gw; it < NITEMS; it += NGW) {
        int r = it;
        if (r < 2 * I_UP) { const int s = r >= I_UP ? 1 : 0; r -= s * I_UP; transpose_item<true>(inp(I_FWIN) + (size_t)(l * 2 + s) * D * FF2, D, FF2, (bf16*)(ws + WS_WT + WT_UP + s * 44 * MiB), scr, r, lane); continue; } r -= 2 * I_UP;
        if (r < 2 * I_DN) { const int s = r >= I_DN ? 1 : 0; r -= s * I_DN; transpose_item<false>(inp(I_FWOUT) + (size_t)(l * 2 + s) * FF * D, FF, D, (bf16*)(ws + WS_WT + WT_DN + s * 22 * MiB), scr, r, lane); continue; } r -= 2 * I_DN;
        if (r < I_INW) { transpose_item<false>(inp(I_WIN) + (size_t)l * D * INW, D, INW, (bf16*)(ws + WS_WT + WT_IN), scr, r, lane); continue; } r -= I_INW;
        if (r < I_BRW) { transpose_item<false>(inp(I_WBR) + (size_t)l * D * D, D, D, (bf16*)(ws + WS_WT + WT_BR), scr, r, lane); continue; } r -= I_BRW;
        if (r < I_BGW) { transpose_item<false>(inp(I_WBG) + (size_t)l * 1024 * D, 1024, D, (bf16*)(ws + WS_WT + WT_BG), scr, r, lane); continue; } r -= I_BGW;
        if (r < I_BGW) { transpose_item<false>(inp(I_WBN) + (size_t)l * 1024 * D, 1024, D, (bf16*)(ws + WS_WT + WT_BN), scr, r, lane); continue; } r -= I_BGW;
        transpose_item<false>(inp(I_WOUT) + (size_t)l * D * D, D, D, (bf16*)(ws + WS_WT + WT_OUT), scr, r, lane);
    }
    (void)WT;
}

template <bool INIT, bool UPD, bool NXT>
__device__ __forceinline__ void thin_phase(const Args& a, const int lu, const int iu, const float res_w, const int ln_, const int in_, const int vcu, const int G) {
    int tid = threadIdx.x; asm volatile("" : "+v"(tid)); const int lane = tid & 63, wave = __builtin_amdgcn_readfirstlane(tid >> 6);
    const float* MOD = (const float*)(wsp(a) + WS_MOD);
    float* X = outp(a) + OUT_X; const bf16* Y = (const bf16*)(wsp(a) + WS_Y); bf16* H = (bf16*)(wsp(a) + WS_H);
    const int gw = vcu * NWAVES + wave, NGW = G * NWAVES;
    for (int blk = gw; blk < M / 8; blk += NGW) {
        const int row0 = blk * 8; const int midx = row0 < MC ? 0 : 1 + ((row0 - MC) >> 10);
        f32x4 ca[8], cb[8], cc[8];
        if (UPD) { const float* gate = MOD + (size_t)(lu * NMODV + midx) * NMODW + (3 * iu + 2) * D; const float* gp = inp(I_NPOST) + (size_t)(lu * 3 + iu) * D;
#pragma unroll
            for (int j = 0; j < 8; ++j) { const int c = 4 * lane + 256 * j; ca[j] = *(const f32x4*)(gate + c) * *(const f32x4*)(gp + c) * res_w; } }
        if (NXT) { const float* sh = MOD + (size_t)(ln_ * NMODV + midx) * NMODW + (3 * in_ + 0) * D; const float* scl = sh + D; const float* gpre = inp(I_NPRE) + (size_t)(ln_ * 3 + in_) * D;
#pragma unroll
            for (int j = 0; j < 8; ++j) { const int c = 4 * lane + 256 * j; cb[j] = *(const f32x4*)(gpre + c) * (*(const f32x4*)(scl + c) + 1.0f); cc[j] = *(const f32x4*)(sh + c); } }
        for (int rr = 0; rr < 8; ++rr) {
            const int row = row0 + rr;
            const float* xin = INIT ? (row < MC ? inp(I_XP) + (size_t)row * D : inp(I_XS) + (size_t)(row - MC) * D) : X + (size_t)row * D;
            f32x4 x[8];
#pragma unroll
            for (int j = 0; j < 8; ++j) x[j] = *(const f32x4*)(xin + 4 * lane + 256 * j);
            if (UPD) { f32x4 y[8]; float ss = 0.f;
#pragma unroll
                for (int j = 0; j < 8; ++j) { const v2u yw = *(const v2u*)(Y + (size_t)row * D + 4 * lane + 256 * j); y[j] = (f32x4){bflo(yw.x), bfhi(yw.x), bflo(yw.y), bfhi(yw.y)}; ss += (y[j][0] * y[j][0] + y[j][1] * y[j][1]) + (y[j][2] * y[j][2] + y[j][3] * y[j][3]); }
                const float rstd = 1.0f / sqrtf(wave_sum(ss) * (1.0f / D) + NORM_EPS);
#pragma unroll
                for (int j = 0; j < 8; ++j) x[j] += ca[j] * (y[j] * rstd); }
            if (UPD || INIT) {
#pragma unroll
                for (int j = 0; j < 8; ++j) *(f32x4*)(X + (size_t)row * D + 4 * lane + 256 * j) = x[j]; }
            if (NXT) { float ss = 0.f;
#pragma unroll
                for (int j = 0; j < 8; ++j) ss += (x[j][0] * x[j][0] + x[j][1] * x[j][1]) + (x[j][2] * x[j][2] + x[j][3] * x[j][3]);
                const float rstd = 1.0f / sqrtf(wave_sum(ss) * (1.0f / D) + NORM_EPS);
#pragma unroll
                for (int j = 0; j < 8; ++j) { const f32x4 h = (x[j] * rstd) * cb[j] + cc[j]; v2u w; w.x = pk2(h[0], h[1]); w.y = pk2(h[2], h[3]);
                    *(v2u*)(H + (size_t)row * D + 4 * lane + 256 * j) = w; } }
        }
    }
}

constexpr int PK = 136, PV = 264;
__device__ __forceinline__ float log_decay(const Args& a, int l, int dir, int h) { const float x = inp(I_RDL)[(l * 2 + dir) * 8 + h]; return -log1pf(expf(-x)); }

template <int WMODE>
__device__ __forceinline__ void stage_qk(LAS bf16* dst, const bf16* Z, const float* ROT, const size_t tok0, const int col0, const bool rotary, const int t0, const float wscale, const float lgw, const int tid) {
#pragma unroll
    for (int it = 0; it < 2; ++it) {
        const int item = tid + 512 * it;
        const int j = item >> 3, hf = (item >> 2) & 1, u = item & 3;
        const int c1 = 64 * hf + 8 * u, c2 = c1 + 32;
        const bf16* src = Z + (tok0 + j) * INW + col0;
        const v4u w1 = *(const v4u*)(src + c1), w2 = *(const v4u*)(src + c2);
        float x1[8], x2[8];
        x1[0] = bflo(w1.x); x1[1] = bfhi(w1.x); x1[2] = bflo(w1.y); x1[3] = bfhi(w1.y); x1[4] = bflo(w1.z); x1[5] = bfhi(w1.z); x1[6] = bflo(w1.w); x1[7] = bfhi(w1.w);
        x2[0] = bflo(w2.x); x2[1] = bfhi(w2.x); x2[2] = bflo(w2.y); x2[3] = bfhi(w2.y); x2[4] = bflo(w2.z); x2[5] = bfhi(w2.z); x2[6] = bflo(w2.w); x2[7] = bfhi(w2.w);
        float wj = wscale;
        if (WMODE == 1) wj *= expf(lgw * (float)(127 - j));
        if (WMODE == 2) wj *= expf(lgw * (float)j);
        float o1[8], o2[8];
        if (rotary) { const int t = t0 + j; const int pos = hf == 0 ? (t >> 6) : (t & 63); const f32x4* rp = (const f32x4*)(ROT + (size_t)(pos * 32 + 8 * u) * 2);
#pragma unroll
            for (int e2 = 0; e2 < 4; ++e2) { const f32x4 cs = rp[e2];
                o1[2 * e2] = (x1[2 * e2] * cs[0] - x2[2 * e2] * cs[1]) * wj; o2[2 * e2] = (x1[2 * e2] * cs[1] + x2[2 * e2] * cs[0]) * wj;
                o1[2 * e2 + 1] = (x1[2 * e2 + 1] * cs[2] - x2[2 * e2 + 1] * cs[3]) * wj; o2[2 * e2 + 1] = (x1[2 * e2 + 1] * cs[3] + x2[2 * e2 + 1] * cs[2]) * wj; } }
        else {
#pragma unroll
            for (int e = 0; e < 8; ++e) { o1[e] = x1[e] * wj; o2[e] = x2[e] * wj; } }
        v4u p1, p2; p1.x = pk2(o1[0], o1[1]); p1.y = pk2(o1[2], o1[3]); p1.z = pk2(o1[4], o1[5]); p1.w = pk2(o1[6], o1[7]);
        p2.x = pk2(o2[0], o2[1]); p2.y = pk2(o2[2], o2[3]); p2.z = pk2(o2[4], o2[5]); p2.w = pk2(o2[6], o2[7]);
        *(LAS v4u*)(dst + j * PK + c1) = p1; *(LAS v4u*)(dst + j * PK + c2) = p2;
    }
}
template <int ROWS, int COLS> __device__ __forceinline__ void stage_copy(LAS bf16* dst, const int pitch, const bf16* src, const size_t ld, const int t, const int nt) {
    constexpr int CPR = COLS / 8;
    for (int c = t; c < ROWS * CPR; c += nt) { const int r = c / CPR, cc = c - r * CPR; *(LAS v4u*)(dst + r * pitch + 8 * cc) = *(const v4u*)(src + (size_t)r * ld + 8 * cc); }
}

__device__ __forceinline__ size_t st_index(int grp, int b, int h, int n, int dir) { return grp ? (size_t)1024 + ((size_t)((b * 8 + h) * 8 + n)) * 2 + dir : ((size_t)((b * 8 + h) * 2 + n)) * 2 + dir; }
__device__ __forceinline__ void ret_chain(const Args& a, const int l, LAS unsigned char* lds, const int grp, const int b, const int h, const int dir) {
    int tid = threadIdx.x; asm volatile("" : "+v"(tid)); const int lane = tid & 63, wave = __builtin_amdgcn_readfirstlane(tid >> 6);
    const bf16* Z = (const bf16*)(wsp(a) + WS_Z); const float* ROT = (const float*)(wsp(a) + WS_ROT); bf16* ST = (bf16*)(wsp(a) + WS_Y);
    const int NCH = grp ? 8 : 2; const size_t rowbase = grp ? (size_t)MC + (size_t)b * 1024 : (size_t)b * 256;
    LAS bf16* Kw = (LAS bf16*)lds; LAS bf16* Vs = Kw + 128 * PK;
    const float lg = log_decay(a, l, dir, h); const float gch = expf(lg * 128.0f);
    const int g4 = 4 * (lane >> 4), li = lane & 15;
    f32x4 acc[8][2];
    if (grp) { const float* p = inp(I_SR) + ((size_t)(((b * 2 + l) * 2 + dir) * 8 + h)) * 128 * 256 + g4 * 256 + 32 * wave + li;
#pragma unroll
        for (int mt = 0; mt < 8; ++mt) {
#pragma unroll
            for (int nt = 0; nt < 2; ++nt)
#pragma unroll
                for (int r = 0; r < 4; ++r) acc[mt][nt][r] = p[r * 256 + 16 * nt];
            p += 16 * 256; asm volatile("" : "+v"(p)); } }
    else {
#pragma unroll
        for (int mt = 0; mt < 8; ++mt)
#pragma unroll
            for (int nt = 0; nt < 2; ++nt) acc[mt][nt] = (f32x4){0.f, 0.f, 0.f, 0.f}; }
    for (int step = 0; step < NCH; ++step) {
        const int n = dir ? NCH - 1 - step : step;
        __syncthreads();
        if (dir == 0) stage_qk<1>(Kw, Z, ROT, rowbase + (size_t)n * 128, ZC_RK + h * 128, grp != 0, n * 128, 0.08838834764831845f, lg, tid);
        else          stage_qk<2>(Kw, Z, ROT, rowbase + (size_t)n * 128, ZC_RK + h * 128, grp != 0, n * 128, 0.08838834764831845f, lg, tid);
        stage_copy<128, 256>(Vs, PV, Z + (rowbase + (size_t)n * 128) * INW + ZC_RV + h * 256, INW, tid, 512);
        bf16* st = ST + st_index(grp, b, h, n, dir) * 32768;
#pragma unroll
        for (int mt = 0; mt < 8; ++mt)
#pragma unroll
            for (int nt = 0; nt < 2; ++nt) { v2u w; w.x = pk2(acc[mt][nt][0], acc[mt][nt][1]); w.y = pk2(acc[mt][nt][2], acc[mt][nt][3]);
                *(v2u*)(st + (size_t)(32 * wave + 16 * nt + li) * 128 + 16 * mt + g4) = w; acc[mt][nt] *= gch; }
        __syncthreads();
#pragma unroll 1
        for (int ks = 0; ks < 4; ++ks) { bf16x8 bv[2];
#pragma unroll
            for (int nt = 0; nt < 2; ++nt) bv[nt] = frag_ck(Vs, PV, 32 * ks, 32 * wave + 16 * nt, lane);
#pragma unroll
            for (int mt = 0; mt < 8; ++mt) { const bf16x8 ak = frag_ck(Kw, PK, 32 * ks, 16 * mt, lane);
#pragma unroll
                for (int nt = 0; nt < 2; ++nt) acc[mt][nt] = MFMA16(ak, bv[nt], acc[mt][nt]); } }
    }
    if (!grp) { float* p = outp(a) + OUT_ST + ((size_t)(((b * 2 + l) * 2 + dir) * 8 + h)) * 128 * 256 + g4 * 256 + 32 * wave + li;
#pragma unroll
        for (int mt = 0; mt < 8; ++mt) {
#pragma unroll
            for (int nt = 0; nt < 2; ++nt)
#pragma unroll
                for (int r = 0; r < 4; ++r) p[r * 256 + 16 * nt] = acc[mt][nt][r];
            p += 16 * 256; asm volatile("" : "+v"(p)); } }
}

__device__ __forceinline__ void ret_out_unit(const Args& a, const int l, LAS unsigned char* lds, const int grp, const int b, const int h, const int n) {
    int tid = threadIdx.x; asm volatile("" : "+v"(tid)); const int lane = tid & 63, wave = __builtin_amdgcn_readfirstlane(tid >> 6);
    const bf16* Z = (const bf16*)(wsp(a) + WS_Z); const float* ROT = (const float*)(wsp(a) + WS_ROT); const bf16* ST = (const bf16*)(wsp(a) + WS_Y); bf16* RET = (bf16*)(wsp(a) + WS_RET);
    const size_t tok0 = (grp ? (size_t)MC + (size_t)b * 1024 : (size_t)b * 256) + (size_t)n * 128;
    LAS bf16* Qs = (LAS bf16*)lds; LAS bf16* KP = Qs + 128 * PK; LAS bf16* Vs = KP + 128 * PK; LAS float* RED = (LAS float*)(Vs + 128 * PV);
    const float l2f = log_decay(a, l, 0, h) * LOG2E, l2b = log_decay(a, l, 1, h) * LOG2E;
    const int g4 = 4 * (lane >> 4), li = lane & 15;
    __syncthreads();
    stage_qk<0>(Qs, Z, ROT, tok0, ZC_RQ + h * 128, grp != 0, n * 128, 1.0f, 0.f, tid);
    stage_qk<0>(KP, Z, ROT, tok0, ZC_RK + h * 128, grp != 0, n * 128, 0.08838834764831845f, 0.f, tid);
    stage_copy<128, 256>(Vs, PV, Z + tok0 * INW + ZC_RV + h * 256, INW, tid, 512);
    __syncthreads();
    { f32x4 s[8];
#pragma unroll
        for (int mt = 0; mt < 8; ++mt) s[mt] = (f32x4){0.f, 0.f, 0.f, 0.f};
#pragma unroll 1
        for (int ks = 0; ks < 4; ++ks) { const bf16x8 bq = frag_rk(Qs, PK, 16 * wave, 32 * ks, lane);
#pragma unroll
            for (int mt = 0; mt < 8; ++mt) s[mt] = MFMA16(frag_rk(KP, PK, 16 * mt, 32 * ks, lane), bq, s[mt]); }
        const int i = 16 * wave + li;
        __syncthreads();
#pragma unroll
        for (int mt = 0; mt < 8; ++mt) { float pv[4];
#pragma unroll
            for (int r = 0; r < 4; ++r) { const int j = 16 * mt + g4 + r; const float dij = (float)(i - j);
                const float w = (dij >= 0.f ? __builtin_amdgcn_exp2f(l2f * dij) : 0.f) + (dij <= 0.f ? __builtin_amdgcn_exp2f(-l2b * dij) : 0.f); pv[r] = s[mt][r] * w; }
            v2u w2; w2.x = pk2(pv[0], pv[1]); w2.y = pk2(pv[2], pv[3]); *(LAS v2u*)(KP + i * PK + 16 * mt + g4) = w2; }
    }
    __syncthreads();
    f32x4 o[2][8];
#pragma unroll
    for (int mt = 0; mt < 2; ++mt)
#pragma unroll
        for (int nt = 0; nt < 8; ++nt) o[mt][nt] = (f32x4){0.f, 0.f, 0.f, 0.f};
#pragma unroll
    for (int dd = 0; dd < 2; ++dd) {
        const bf16* st = ST + st_index(grp, b, h, n, dd) * 32768;
#pragma unroll 1
        for (int ks = 0; ks < 4; ++ks) { bf16x8 af[2];
#pragma unroll
            for (int mt = 0; mt < 2; ++mt) af[mt] = *(const bf16x8*)(st + (size_t)(32 * wave + 16 * mt + li) * 128 + 32 * ks + 2 * g4);
#pragma unroll
            for (int nt = 0; nt < 8; ++nt) { const bf16x8 bq = frag_rk(Qs, PK, 16 * nt, 32 * ks, lane);
#pragma unroll
                for (int mt = 0; mt < 2; ++mt) o[mt][nt] = MFMA16(af[mt], bq, o[mt][nt]); } }
#pragma unroll
        for (int nt = 0; nt < 8; ++nt) { const float fi = (float)(16 * nt + li);
            const float sc = dd == 0 ? __builtin_amdgcn_exp2f(l2f * (fi + 1.0f) - l2b * (128.0f - fi)) : __builtin_amdgcn_exp2f(l2b * (128.0f - fi));
#pragma unroll
            for (int mt = 0; mt < 2; ++mt) o[mt][nt] *= sc; }
    }
#pragma unroll 1
    for (int ks = 0; ks < 4; ++ks) { bf16x8 av[2];
#pragma unroll
        for (int mt = 0; mt < 2; ++mt) av[mt] = frag_ck(Vs, PV, 32 * ks, 32 * wave + 16 * mt, lane);
#pragma unroll
        for (int nt = 0; nt < 8; ++nt) { const bf16x8 bp = frag_rk(KP, PK, 16 * nt, 32 * ks, lane);
#pragma unroll
            for (int mt = 0; mt < 2; ++mt) o[mt][nt] = MFMA16(av[mt], bp, o[mt][nt]); } }
#pragma unroll
    for (int nt = 0; nt < 8; ++nt) { float ss = 0.f;
#pragma unroll
        for (int mt = 0; mt < 2; ++mt) ss += (o[mt][nt][0] * o[mt][nt][0] + o[mt][nt][1] * o[mt][nt][1]) + (o[mt][nt][2] * o[mt][nt][2] + o[mt][nt][3] * o[mt][nt][3]);
        ss += __shfl_xor(ss, 16); ss += __shfl_xor(ss, 32);
        if (lane < 16) RED[wave * 128 + 16 * nt + lane] = ss; }
    __syncthreads();
#pragma unroll
    for (int nt = 0; nt < 8; ++nt) { const int i = 16 * nt + li; float tot = 0.f;
#pragma unroll
        for (int w = 0; w < 8; ++w) tot += RED[w * 128 + i];
        const float rstd = 1.0f / sqrtf(tot * (1.0f / 256.0f) + NORM_EPS);
        const bf16* gp = Z + (tok0 + i) * INW + ZC_RG + h * 256 + 32 * wave + g4; bf16* op = RET + (tok0 + i) * D + h * 256 + 32 * wave + g4;
#pragma unroll
        for (int mt = 0; mt < 2; ++mt) { const v2u gw = *(const v2u*)(gp + 16 * mt); const f32x4 v = o[mt][nt] * rstd;
            v2u w; w.x = pk2(v[0] * pg8::silu_f(bflo(gw.x)), v[1] * pg8::silu_f(bfhi(gw.x))); w.y = pk2(v[2] * pg8::silu_f(bflo(gw.y)), v[3] * pg8::silu_f(bfhi(gw.y)));
            *(v2u*)(op + 16 * mt) = w; } }
}

__device__ __forceinline__ void gmlp_unit(const Args& a, const int l, LAS unsigned char* lds, const int grp, const int b, const int n, const int g) {
    int tid = threadIdx.x; asm volatile("" : "+v"(tid)); const int lane = tid & 63, wave = __builtin_amdgcn_readfirstlane(tid >> 6);
    const bf16* Z = (const bf16*)(wsp(a) + WS_Z); bf16* GMo = (bf16*)(wsp(a) + WS_GM);
    const size_t tok0 = (grp ? (size_t)MC + (size_t)b * 1024 : (size_t)b * 256) + (size_t)n * 128;
    LAS bf16* VN = (LAS bf16*)lds; LAS bf16* WS = VN + 128 * PV; LAS f32x2* STAT = (LAS f32x2*)(WS + 128 * PK);
    const int g4 = 4 * (lane >> 4), li = lane & 15;
    __syncthreads();
    for (int tt = 0; tt < 16; ++tt) { const int j = 16 * wave + tt; const bf16* vp = Z + (tok0 + j) * INW + ZC_GV;
        const v4u w1 = *(const v4u*)(vp + 8 * lane), w2 = *(const v4u*)(vp + 512 + 8 * lane);
        float x[16]; x[0] = bflo(w1.x); x[1] = bfhi(w1.x); x[2] = bflo(w1.y); x[3] = bfhi(w1.y); x[4] = bflo(w1.z); x[5] = bfhi(w1.z); x[6] = bflo(w1.w); x[7] = bfhi(w1.w);
        x[8] = bflo(w2.x); x[9] = bfhi(w2.x); x[10] = bflo(w2.y); x[11] = bfhi(w2.y); x[12] = bflo(w2.z); x[13] = bfhi(w2.z); x[14] = bflo(w2.w); x[15] = bfhi(w2.w);
        float s = 0.f;
#pragma unroll
        for (int e = 0; e < 16; ++e) s += x[e];
        const float mean = wave_sum(s) * (1.0f / 1024.0f); float q = 0.f;
#pragma unroll
        for (int e = 0; e < 16; ++e) { const float d = x[e] - mean; q += d * d; }
        const float rstd = 1.0f / sqrtf(wave_sum(q) * (1.0f / 1024.0f) + NORM_EPS);
        if (lane == 0) STAT[j] = (f32x2){mean, rstd}; }
    { const float* wsrc = inp(I_GMWS) + (size_t)(l * 4 + g) * 128 * 128;
        for (int c = tid; c < 128 * 32; c += 512) { const int r = c >> 5, cc = c & 31; const f32x4 v = *(const f32x4*)(wsrc + r * 128 + 4 * cc); v2u w; w.x = pk2(v[0], v[1]); w.y = pk2(v[2], v[3]); *(LAS v2u*)(WS + r * PK + 4 * cc) = w; } }
    __syncthreads();
    { const float* gn = inp(I_GMN) + l * 1024 + g * 256;
        for (int c = tid; c < 128 * 32; c += 512) { const int j = c >> 5, cc = c & 31; const v4u w1 = *(const v4u*)(Z + (tok0 + j) * INW + ZC_GV + g * 256 + 8 * cc);
            const f32x2 st = STAT[j]; const f32x4 n0 = *(const f32x4*)(gn + 8 * cc), n1 = *(const f32x4*)(gn + 8 * cc + 4);
            v4u o; o.x = pk2((bflo(w1.x) - st.x) * st.y * n0[0], (bfhi(w1.x) - st.x) * st.y * n0[1]); o.y = pk2((bflo(w1.y) - st.x) * st.y * n0[2], (bfhi(w1.y) - st.x) * st.y * n0[3]);
            o.z = pk2((bflo(w1.z) - st.x) * st.y * n1[0], (bfhi(w1.z) - st.x) * st.y * n1[1]); o.w = pk2((bflo(w1.w) - st.x) * st.y * n1[2], (bfhi(w1.w) - st.x) * st.y * n1[3]);
            *(LAS v4u*)(VN + j * PV + 8 * cc) = o; } }
    __syncthreads();
    f32x4 o[2][8];
#pragma unroll
    for (int mt = 0; mt < 2; ++mt)
#pragma unroll
        for (int nt = 0; nt < 8; ++nt) o[mt][nt] = (f32x4){0.f, 0.f, 0.f, 0.f};
#pragma unroll 1
    for (int ks = 0; ks < 4; ++ks) { bf16x8 av[2];
#pragma unroll
        for (int mt = 0; mt < 2; ++mt) av[mt] = frag_ck(VN, PV, 32 * ks, 32 * wave + 16 * mt, lane);
#pragma unroll
        for (int nt = 0; nt < 8; ++nt) { const bf16x8 bw = frag_rk(WS, PK, 16 * nt, 32 * ks, lane);
#pragma unroll
            for (int mt = 0; mt < 2; ++mt) o[mt][nt] = MFMA16(av[mt], bw, o[mt][nt]); } }
#pragma unroll
    for (int nt = 0; nt < 8; ++nt) { const int i = 16 * nt + li; const float bias = inp(I_GMBS)[(l * 4 + g) * 128 + i];
        const bf16* up = Z + (tok0 + i) * INW + ZC_GU + g * 256 + 32 * wave + g4; bf16* op = GMo + (tok0 + i) * 1024 + g * 256 + 32 * wave + g4;
#pragma unroll
        for (int mt = 0; mt < 2; ++mt) { const v2u uw = *(const v2u*)(up + 16 * mt); const f32x4 v = o[mt][nt] + bias;
            v2u w; w.x = pk2(v[0] * bflo(uw.x), v[1] * bfhi(uw.x)); w.y = pk2(v[2] * bflo(uw.y), v[3] * bfhi(uw.y)); *(v2u*)(op + 16 * mt) = w; } }
}

template <int NT, bool LOCAL>
__device__ __forceinline__ void attn_chunk(const LAS bf16* KT, const LAS bf16* VT, const bf16x8 (&qf)[4], f32x4 (&o)[8], float& m, float& lsum, const int lane,
                                           const int cs, const float* rpbh, const int roff0, const int qc) {
    const int g4 = 4 * (lane >> 4);
    f32x4 s[NT];
#pragma unroll
    for (int kt = 0; kt < NT; ++kt) { const int row0 = LOCAL ? 64 * (kt >> 1) + cs + 16 * (kt & 1) : 16 * kt; s[kt] = (f32x4){0.f, 0.f, 0.f, 0.f};
#pragma unroll
        for (int ks = 0; ks < 4; ++ks) s[kt] = MFMA16(frag_rk(KT, PK, row0, 32 * ks, lane), qf[ks], s[kt]); }
    const float sc2 = 0.08838834764831845f * LOG2E;
    float cmax = -1e30f;
#pragma unroll
    for (int kt = 0; kt < NT; ++kt)
#pragma unroll
        for (int r = 0; r < 4; ++r) { float v = s[kt][r] * sc2;
            if (LOCAL) { const int kc = cs + 16 * (kt & 1) + g4 + r; const int cst = min(max(qc - 8, 0), 48); const bool valid = (kc >= cst) && (kc < cst + 16);
                const float bias = rpbh[(roff0 + (kt >> 1)) * 31 + min(max(kc - qc + 15, 0), 30)]; v = valid ? v + bias * LOG2E : -1e30f; }
            s[kt][r] = v; cmax = fmaxf(cmax, v); }
    cmax = fmaxf(cmax, __shfl_xor(cmax, 16)); cmax = fmaxf(cmax, __shfl_xor(cmax, 32));
    const float mnew = fmaxf(m, cmax), alpha = __builtin_amdgcn_exp2f(m - mnew); m = mnew;
    float csum = 0.f;
#pragma unroll
    for (int kt = 0; kt < NT; ++kt)
#pragma unroll
        for (int r = 0; r < 4; ++r) { const float p = __builtin_amdgcn_exp2f(s[kt][r] - mnew); s[kt][r] = p; csum += p; }
    csum += __shfl_xor(csum, 16); csum += __shfl_xor(csum, 32);
    lsum = lsum * alpha + csum;
#pragma unroll
    for (int et = 0; et < 8; ++et) o[et] *= alpha;
#pragma unroll
    for (int pr = 0; pr < NT / 2; ++pr) {
        const int rowA = LOCAL ? 64 * pr + cs : 32 * pr, rowB = rowA + 16;
        v4u pw; pw.x = pk2(s[2 * pr][0], s[2 * pr][1]); pw.y = pk2(s[2 * pr][2], s[2 * pr][3]); pw.z = pk2(s[2 * pr + 1][0], s[2 * pr + 1][1]); pw.w = pk2(s[2 * pr + 1][2], s[2 * pr + 1][3]);
        const bf16x8 pb = __builtin_bit_cast(bf16x8, pw);
#pragma unroll
        for (int et = 0; et < 8; ++et) o[et] = MFMA16(frag_ck2(VT, PK, rowA, rowB, 16 * et, lane), pb, o[et]);
    }
}
__device__ __forceinline__ void attn_dense_unit(const Args& a, LAS unsigned char* lds, const int b, const int h, const int qb) {
    int tid = threadIdx.x; asm volatile("" : "+v"(tid)); const int lane = tid & 63, wave = __builtin_amdgcn_readfirstlane(tid >> 6);
    const bf16* Z = (const bf16*)(wsp(a) + WS_Z); bf16* NAo = (bf16*)(wsp(a) + WS_NA);
    LAS bf16* KT = (LAS bf16*)lds; LAS bf16* VT = KT + 128 * PK;
    const int g4 = 4 * (lane >> 4), li = lane & 15;
    const size_t qtok = (size_t)b * 256 + (size_t)qb * 128 + 16 * wave + li;
    bf16x8 qf[4];
#pragma unroll
    for (int ks = 0; ks < 4; ++ks) qf[ks] = *(const bf16x8*)(Z + qtok * INW + ZC_NQ + h * 128 + 32 * ks + 2 * g4);
    f32x4 o[8];
#pragma unroll
    for (int et = 0; et < 8; ++et) o[et] = (f32x4){0.f, 0.f, 0.f, 0.f};
    float m = -1e30f, lsum = 0.f;
    for (int ch = 0; ch < 2; ++ch) {
        __syncthreads();
        const bf16* src = Z + ((size_t)b * 256 + (size_t)ch * 128) * INW + h * 128;
        stage_copy<128, 128>(KT, PK, src + ZC_NK, INW, tid, 512); stage_copy<128, 128>(VT, PK, src + ZC_NV, INW, tid, 512);
        __syncthreads();
        attn_chunk<8, false>(KT, VT, qf, o, m, lsum, lane, 0, nullptr, 0, 0);
    }
    const float inv = 1.0f / lsum;
    bf16* op = NAo + qtok * 1024 + h * 128 + g4;
#pragma unroll
    for (int et = 0; et < 8; ++et) { v2u w; w.x = pk2(o[et][0] * inv, o[et][1] * inv); w.y = pk2(o[et][2] * inv, o[et][3] * inv); *(v2u*)(op + 16 * et) = w; }
}
__device__ __forceinline__ void attn_na_unit(const Args& a, const int l, LAS unsigned char* lds, const int b, const int r, const int hp) {
    int tid = threadIdx.x; asm volatile("" : "+v"(tid)); const int lane = tid & 63, wave = __builtin_amdgcn_readfirstlane(tid >> 6);
    const bf16* Z = (const bf16*)(wsp(a) + WS_Z); bf16* NAo = (bf16*)(wsp(a) + WS_NA);
    const int hg = wave >> 2, h = 2 * hp + hg, qa = wave & 3, gt = tid & 255;
    LAS bf16* KT = (LAS bf16*)lds + hg * (2 * 128 * PK); LAS bf16* VT = KT + 128 * PK;
    const int g4 = 4 * (lane >> 4), li = lane & 15;
    const int qc = 16 * qa + li;
    const size_t qtok = (size_t)MC + (size_t)b * 1024 + (size_t)r * 64 + qc;
    const int cs = qa == 0 ? 0 : (qa == 1 ? 8 : (qa == 2 ? 24 : 32));
    const int rs = min(max(r - 4, 0), 8);
    const float* rpbh = inp(I_RPB) + (size_t)(l * 8 + h) * 15 * 31;
    bf16x8 qf[4];
#pragma unroll
    for (int ks = 0; ks < 4; ++ks) qf[ks] = *(const bf16x8*)(Z + qtok * INW + ZC_NQ + h * 128 + 32 * ks + 2 * g4);
    f32x4 o[8];
#pragma unroll
    for (int et = 0; et < 8; ++et) o[et] = (f32x4){0.f, 0.f, 0.f, 0.f};
    float m = -1e30f, lsum = 0.f;
    for (int ch = 0; ch < 4; ++ch) {
        __syncthreads();
        const bf16* src = Z + ((size_t)MC + (size_t)b * 1024 + (size_t)(rs + 2 * ch) * 64) * INW + h * 128;
        stage_copy<128, 128>(KT, PK, src + ZC_NK, INW, gt, 256); stage_copy<128, 128>(VT, PK, src + ZC_NV, INW, gt, 256);
        __syncthreads();
        attn_chunk<4, true>(KT, VT, qf, o, m, lsum, lane, cs, rpbh, rs + 2 * ch - r + 7, qc);
    }
    for (int ch = 0; ch < 2; ++ch) {
        __syncthreads();
        const float* ksrc = inp(I_CK) + ((size_t)((b * 2 + l) * 256 + ch * 128) * 8 + h) * 128;
        const float* vsrc = inp(I_CV) + ((size_t)((b * 2 + l) * 256 + ch * 128) * 8 + h) * 128;
        for (int c = gt; c < 128 * 16; c += 256) { const int rr = c >> 4, cc = c & 15;
            const f32x4 k0 = *(const f32x4*)(ksrc + (size_t)rr * 1024 + 8 * cc), k1 = *(const f32x4*)(ksrc + (size_t)rr * 1024 + 8 * cc + 4);
            const f32x4 v0 = *(const f32x4*)(vsrc + (size_t)rr * 1024 + 8 * cc), v1 = *(const f32x4*)(vsrc + (size_t)rr * 1024 + 8 * cc + 4);
            v4u kw, vw; kw.x = pk2(k0[0], k0[1]); kw.y = pk2(k0[2], k0[3]); kw.z = pk2(k1[0], k1[1]); kw.w = pk2(k1[2], k1[3]);
            vw.x = pk2(v0[0], v0[1]); vw.y = pk2(v0[2], v0[3]); vw.z = pk2(v1[0], v1[1]); vw.w = pk2(v1[2], v1[3]);
            *(LAS v4u*)(KT + rr * PK + 8 * cc) = kw; *(LAS v4u*)(VT + rr * PK + 8 * cc) = vw; }
        __syncthreads();
        attn_chunk<8, false>(KT, VT, qf, o, m, lsum, lane, 0, nullptr, 0, 0);
    }
    const float inv = 1.0f / lsum;
    bf16* op = NAo + qtok * 1024 + h * 128 + g4;
#pragma unroll
    for (int et = 0; et < 8; ++et) { v2u w; w.x = pk2(o[et][0] * inv, o[et][1] * inv); w.y = pk2(o[et][2] * inv, o[et][3] * inv); *(v2u*)(op + 16 * et) = w; }
}
#ifndef REP_GEMM
#define REP_GEMM 1
#endif
#ifndef REP_THIN
#define REP_THIN 1
#endif
#ifndef REP_CONV
#define REP_CONV 1
#endif
#ifndef REP_MIX1
#define REP_MIX1 1
#endif
#ifndef REP_MIX2
#define REP_MIX2 1
#endif
#ifndef REP_UP
#define REP_UP REP_GEMM
#endif
#ifndef REP_DN
#define REP_DN REP_GEMM
#endif
#ifndef REP_IN
#define REP_IN REP_GEMM
#endif
#ifndef REP_BR
#define REP_BR REP_GEMM
#endif
#ifndef REP_OUT
#define REP_OUT REP_GEMM
#endif
#ifndef REP_BAR
#define REP_BAR 1
#endif
#ifndef REP_R1
#define REP_R1 1
#endif
#ifndef REP_GM
#define REP_GM 1
#endif
#ifndef REP_AD
#define REP_AD 1
#endif
#ifndef REP_AN
#define REP_AN 1
#endif
#define REPEAT(n) _Pragma("clang loop unroll(full)") for (int rep_ = 0; rep_ < (n); ++rep_)
#ifndef NLAYER_LOOP
#define NLAYER_LOOP 2
#endif
#ifndef NSUB_LOOP
#define NSUB_LOOP 2
#endif
#ifndef EN_CONV
#define EN_CONV 1
#endif
#ifndef EN_THIN
#define EN_THIN 1
#endif
#ifndef EN_GEMM
#define EN_GEMM 1
#endif
#ifndef EN_R1
#define EN_R1 1
#endif
#ifndef EN_GM
#define EN_GM 1
#endif
#ifndef EN_AD
#define EN_AD 1
#endif
#ifndef EN_AN
#define EN_AN 1
#endif
#ifndef EN_R2
#define EN_R2 1
#endif

#ifndef MK_SPLIT
#define MK_SPLIT 0
#endif
constexpr int NPH = 14;
enum { PH_CONV = 0, PH_INIT, PH_UP0, PH_DN0, PH_THA, PH_IN, PH_MIX1, PH_MIX2, PH_BR, PH_OUT, PH_THB, PH_UP1, PH_DN1, PH_THC };

__global__ void __launch_bounds__(NWAVES * 64, 2) fwd_kernel(Args args) {
    extern __shared__ __attribute__((aligned(16))) unsigned char lds_raw[];
    LAS unsigned char* lds = (LAS unsigned char*)lds_raw;
    volatile LAS unsigned* MISC = (volatile LAS unsigned*)(lds + MISC_OFF);
    const int tid = threadIdx.x;
    const int G = gridDim.x; const int vcu = blockIdx.x;
    for (int u = tid; u < (LDS_BYTES - MISC_OFF) / 4; u += NWAVES * 64) ((LAS unsigned*)(lds + MISC_OFF))[u] = 0u;
    __syncthreads();
    unsigned* barw = (unsigned*)(wsp(args) + WS_CTL) + CW_BAR;
    XcdBarrier bar = xcd_barrier_post(barw, MISC + 8);
    const int lo = args.ph_lo, hi = args.ph_hi;
#define IN(k) (lo <= (k) && (k) < hi)
#define SEAM(k) do { if ((k) + 1 < hi) { for (int rb_ = 0; rb_ < REP_BAR; ++rb_) xcd_barrier(bar); } } while (0)
#pragma clang loop unroll(full)
    for (int l = 0; l < NLAYER_LOOP; ++l) {
        const int pb = l * NPH;
        if (EN_CONV && l == 0 && IN(pb + PH_CONV)) { REPEAT(REP_CONV) conv_phase(args, l, lds, vcu, G); SEAM(pb + PH_CONV); }
        if (l == 0 && IN(pb + PH_INIT)) { REPEAT(REP_THIN) thin_phase<true, false, true>(args, 0, 0, 0.f, 0, 0, vcu, G); SEAM(pb + PH_INIT); }
#pragma clang loop unroll(full)
        for (int s = 0; s < NSUB_LOOP; ++s) {
            if (IN(pb + (s ? PH_UP1 : PH_UP0))) {
                unsigned char* ws = wsp(args);
                pg8::Gemm g{(const pg8::bf16_t*)(ws + WS_H), (const pg8::bf16_t*)(ws + WS_WT + WT_UP + (size_t)s * 44 * MiB), M, FF2, D}; pg8::StaticOrder S; S.init(M, FF2, G, vcu);
                pg8::EpiSwiglu E{(pg8::bf16_t*)(ws + WS_Z), FF};
                REPEAT(REP_UP) pg8::gemm_phase<pg8::EpiSwiglu, pg8::StaticOrder, true, true>(lds, g, S, E);
                SEAM(pb + (s ? PH_UP1 : PH_UP0));
            }
            if (IN(pb + (s ? PH_DN1 : PH_DN0))) {
                unsigned char* ws = wsp(args);
                pg8::Gemm g{(const pg8::bf16_t*)(ws + WS_Z), (const pg8::bf16_t*)(ws + WS_WT + WT_DN + (size_t)s * 22 * MiB), M, D, FF}; pg8::StaticOrder S; S.init(M, D, G, vcu);
                pg8::EpiBf16 E{(pg8::bf16_t*)(ws + WS_Y), D};
                REPEAT(REP_DN) pg8::gemm_phase<pg8::EpiBf16, pg8::StaticOrder, true, true>(lds, g, S, E);
                SEAM(pb + (s ? PH_DN1 : PH_DN0));
            }
            if (s == 0) {
                if (IN(pb + PH_THA)) { REPEAT(REP_THIN) thin_phase<false, true, true>(args, l, 0, rep_ == REP_THIN - 1 ? 0.5f : 0.f, l, 1, vcu, G); SEAM(pb + PH_THA); }
                if (IN(pb + PH_IN)) {
                    unsigned char* ws = wsp(args); float* outb = outp(args);
                    pg8::Gemm g{(const pg8::bf16_t*)(ws + WS_H), (const pg8::bf16_t*)(ws + WS_WT + WT_IN), M, INW, D}; pg8::StaticOrder S; S.init(M, INW, G, vcu);
                    pg8::EpiZ E{(pg8::bf16_t*)(ws + WS_Z), INW, outb + OUT_CK + (size_t)l * 256 * 1024, outb + OUT_CV + (size_t)l * 256 * 1024};
                    REPEAT(REP_IN) pg8::gemm_phase<pg8::EpiZ, pg8::StaticOrder, true, true>(lds, g, S, E);
                    SEAM(pb + PH_IN);
                }
                if (IN(pb + PH_MIX1)) { REPEAT(REP_MIX1) {
                    REPEAT(REP_R1) for (int sl = vcu; sl < 256; sl += G) {
                        const int nch = sl < 128 ? 1 : 4;
                        for (int k = 0; k < nch; ++k) { const int c = sl < 128 ? sl : (sl - 128) * 4 + k; if (EN_R1) ret_chain(args, l, lds, sl < 128 ? 1 : 0, c >> 4, (c >> 1) & 7, c & 1); }
                    }
                    REPEAT(REP_GM) for (int u = vcu; u < 512; u += G) { const int grp = u >> 8, v = u & 255; if (EN_GM) gmlp_unit(args, l, lds, grp, grp ? v >> 5 : v >> 3, grp ? (v >> 2) & 7 : (v >> 2) & 1, v & 3); }
                    REPEAT(REP_AD) for (int u = vcu; u < 512; u += G) if (EN_AD) attn_dense_unit(args, lds, u >> 4, (u >> 1) & 7, u & 1);
                    REPEAT(REP_AN) for (int u = vcu; u < 512; u += G) if (EN_AN) attn_na_unit(args, l, lds, u >> 6, (u >> 2) & 15, u & 3);
                    }
                    SEAM(pb + PH_MIX1);
                }
                if (IN(pb + PH_MIX2)) { REPEAT(REP_MIX2) {
                    for (int u = vcu; u < 1024; u += G) { const int grp = u >> 9, v = u & 511; if (EN_R2) ret_out_unit(args, l, lds, grp, grp ? v >> 6 : v >> 4, grp ? (v >> 3) & 7 : (v >> 1) & 7, grp ? v & 7 : v & 1); }
                    }
                    SEAM(pb + PH_MIX2);
                }
                if (IN(pb + PH_BR)) {
                    unsigned char* ws = wsp(args);
                    pg8::StaticOrder S; S.init(M, D, G, vcu);
                    const pg8::bf16_t* Zb = (const pg8::bf16_t*)(ws + WS_Z);
                    REPEAT(REP_BR) {
                    { pg8::Gemm g{(const pg8::bf16_t*)(ws + WS_RET), (const pg8::bf16_t*)(ws + WS_WT + WT_BR), M, D, D};
                      pg8::EpiMerge<0> E{Zb + ZC_GA, INW, (pg8::bf16_t*)(ws + WS_H), D}; pg8::gemm_phase<pg8::EpiMerge<0>, pg8::StaticOrder, true, true>(lds, g, S, E); }
                    { pg8::Gemm g{(const pg8::bf16_t*)(ws + WS_GM), (const pg8::bf16_t*)(ws + WS_WT + WT_BG), M, D, 1024};
                      pg8::EpiMerge<1> E{Zb + ZC_GA + 2048, INW, (pg8::bf16_t*)(ws + WS_H), D}; pg8::gemm_phase<pg8::EpiMerge<1>, pg8::StaticOrder, true, true>(lds, g, S, E); }
                    { pg8::Gemm g{(const pg8::bf16_t*)(ws + WS_NA), (const pg8::bf16_t*)(ws + WS_WT + WT_BN), M, D, 1024};
                      pg8::EpiMerge<2> E{Zb + ZC_GA + 4096, INW, (pg8::bf16_t*)(ws + WS_H), D}; pg8::gemm_phase<pg8::EpiMerge<2>, pg8::StaticOrder, true, true>(lds, g, S, E); }
                    }
                    SEAM(pb + PH_BR);
                }
                if (IN(pb + PH_OUT)) {
                    unsigned char* ws = wsp(args);
                    pg8::Gemm g{(const pg8::bf16_t*)(ws + WS_H), (const pg8::bf16_t*)(ws + WS_WT + WT_OUT), M, D, D}; pg8::StaticOrder S; S.init(M, D, G, vcu);
                    pg8::EpiBf16 E{(pg8::bf16_t*)(ws + WS_Y), D};
                    REPEAT(REP_OUT) pg8::gemm_phase<pg8::EpiBf16, pg8::StaticOrder, true, true>(lds, g, S, E);
                    SEAM(pb + PH_OUT);
                }
                if (IN(pb + PH_THB)) { REPEAT(REP_THIN) thin_phase<false, true, true>(args, l, 1, rep_ == REP_THIN - 1 ? 1.0f : 0.f, l, 2, vcu, G); SEAM(pb + PH_THB); }
            } else {
                if (IN(pb + PH_THC)) {
                    if (l == 0) { REPEAT(REP_THIN) thin_phase<false, true, true>(args, 0, 2, rep_ == REP_THIN - 1 ? 0.5f : 0.f, 1, 0, vcu, G); REPEAT(REP_CONV) conv_phase(args, 1, lds, vcu, G); }
                    else        { REPEAT(REP_THIN) thin_phase<false, true, false>(args, 1, 2, rep_ == REP_THIN - 1 ? 0.5f : 0.f, 0, 0, vcu, G); }
                    SEAM(pb + PH_THC);
                }
            }
        }
    }
#undef IN
#undef SEAM
}

extern "C" void kernel_launch(void* const* d_in, const int* in_sizes, int n_in, void* d_out, int out_size, void* d_ws, size_t ws_size, hipStream_t stream) {
    static int grid = 0;
    if (grid == 0) {
        if (n_in != N_IN || (size_t)out_size != OUT_TOTAL || ws_size < WS_END) { fprintf(stderr, "kernel_launch: unexpected shapes: n_in %d out %d ws %zu (need %zu); nothing launched\n", n_in, out_size, ws_size, (size_t)WS_END); grid = -1; return; }
        int dev = 0, cus = 0, per_cu = 0;
        if (hipGetDevice(&dev) != hipSuccess || hipDeviceGetAttribute(&cus, hipDeviceAttributeMultiprocessorCount, dev) != hipSuccess) { grid = -1; return; }
        if (hipFuncSetAttribute((const void*)fwd_kernel, hipFuncAttributeMaxDynamicSharedMemorySize, LDS_BYTES) != hipSuccess) { fprintf(stderr, "kernel_launch: hipFuncSetAttribute failed\n"); grid = -1; return; }
        if (hipOccupancyMaxActiveBlocksPerMultiprocessor(&per_cu, (const void*)fwd_kernel, NWAVES * 64, LDS_BYTES) != hipSuccess || per_cu < 1) { fprintf(stderr, "kernel_launch: occupancy query reports %d workgroups per CU\n", per_cu); }
        (void)hipGetLastError();
        grid = cus;
        if (per_cu < 1) grid = -1;
    }
    if (grid < 0) return;
    if (hipMemsetAsync((char*)d_ws + WS_CTL, 0, CTL_ZERO_BYTES, stream) != hipSuccess) return;
    Args a{};
    for (int i = 0; i < N_IN; ++i) a.in[i] = (const float*)d_in[i];
    a.out = (float*)d_out; a.ws = (unsigned char*)d_ws;
#if MK_SPLIT
    for (int p = 0; p < 2 * NPH; ++p) { if (p == NPH + PH_INIT || p == NPH + PH_CONV) continue; a.ph_lo = p; a.ph_hi = p + 1; hipLaunchKernelGGL(fwd_kernel, dim3(grid), dim3(NWAVES * 64), LDS_BYTES, stream, a); }
#else
    a.ph_lo = 0; a.ph_hi = 2 * NPH;
    hipLaunchKernelGGL(fwd_kernel, dim3(grid), dim3(NWAVES * 64), LDS_BYTES, stream, a);
#endif
    const hipError_t le = hipPeekAtLastError();
    if (le != hipSuccess) fprintf(stderr, "kernel_launch: launch failed: %s\n", hipGetErrorName(le));
}
```

```cpp
#include <hip/hip_runtime.h>
#include <cstdio>
#include <cstdint>
namespace pg8 {
#define PG8_LAS __attribute__((address_space(3)))
typedef unsigned short bf16_t;
typedef short bf16x8 __attribute__((ext_vector_type(8)));
typedef float f32x4 __attribute__((ext_vector_type(4)));
typedef unsigned u32x4 __attribute__((ext_vector_type(4)));
constexpr int BM = 256, BK = 64, HALF = 128, HTB = HALF * BK * 2  , STAGE_BYTES = 8 * HTB, NXCD = 8, WGM = 8;

__host__ __device__ __forceinline__ int lds_byte(int r, int c) { const int st = (r >> 4) * 2 + (c >> 5), rr = r & 15, cc = c & 31, ob = rr * 64 + cc * 2; return st * 1024 + (ob ^ (((ob >> 9) & 1) << 5)); }
__host__ __device__ __forceinline__ void stage_rc(int b, int& R, int& C) { const int st = b / 1024, sb = b % 1024, swz = sb ^ (((sb >> 9) & 1) << 5); R = (st >> 1) * 16 + swz / 64; C = (st & 1) * 32 + (swz % 64) / 2; }
__host__ __device__ __forceinline__ int perm32(int rho) { const int n = rho >> 4, i = rho & 15; return 8 * (i >> 2) + 4 * n + (i & 3); }

struct Unit { int pm, pn; };
struct Gemm { const bf16_t* A; const bf16_t* Bt; int M, N, K; };

struct StaticOrder {
    int nM, nN, nwg, G, c;
    __host__ __device__ void init(int M, int N, int G_, int c_) { nM = M / BM; nN = N / BM; nwg = nM * nN; G = G_; c = c_; }
    __host__ __device__ bool next(int i, Unit& u) const {
        const long L = (long)i * G + c; if (L >= nwg) return false;
        int wgid = (int)L; { const int q = nwg / NXCD, r = nwg % NXCD, xcd = wgid % NXCD, off = wgid / NXCD; wgid = (xcd < r ? xcd * (q + 1) : r * (q + 1) + (xcd - r) * q) + off; }
        const int nig = WGM * nN, gid = wgid / nig, fm = gid * WGM, gsz = (nM - fm) < WGM ? (nM - fm) : WGM;
        u.pm = fm + ((wgid % nig) % gsz); u.pn = (wgid % nig) / gsz; return true;
    }
    __device__ __forceinline__ void a_ready(const Unit&) const {}
    __device__ __forceinline__ void done(const Unit&) const {}
};

__device__ __forceinline__ unsigned cvt_pk_bf16(float lo, float hi) { unsigned r; asm volatile("v_cvt_pk_bf16_f32 %0, %1, %2" : "=v"(r) : "v"(lo), "v"(hi)); return r; }
typedef float f32x2 __attribute__((ext_vector_type(2)));
__device__ __forceinline__ float sigm_f(float a) { return __builtin_amdgcn_rcpf(1.0f + __expf(-a)); }
__device__ __forceinline__ float silu_f(float a) { return a * sigm_f(a); }
__device__ __forceinline__ float bf_lo(unsigned w) { return __uint_as_float(w << 16); }
__device__ __forceinline__ float bf_hi(unsigned w) { return __uint_as_float(w & 0xffff0000u); }
struct EpiSwiglu {
    static constexpr bool PERM = true, AFTER_DRAIN = false;
    bf16_t* O; int ldc;
    __device__ __forceinline__ void operator()(const f32x4 (&acc)[2][2][4][2], const Unit& u, int wr, int wc, int fr, int fq) const {
        const int row0 = u.pm * BM + wr * 64 + fr, col0 = u.pn * HALF + wc * 32 + 8 * fq;
#pragma unroll
        for (int ai = 0; ai < 2; ++ai)
#pragma unroll
            for (int m = 0; m < 4; ++m) { bf16_t* rowp = O + (size_t)(row0 + ai * HALF + m * 16) * ldc + col0;
                const f32x4 a0 = acc[ai][0][m][0], a1 = acc[ai][0][m][1], b0 = acc[ai][1][m][0], b1 = acc[ai][1][m][1];
                u32x4 w; w.x = cvt_pk_bf16(silu_f(a0[0]) * b0[0], silu_f(a0[1]) * b0[1]); w.y = cvt_pk_bf16(silu_f(a0[2]) * b0[2], silu_f(a0[3]) * b0[3]);
                w.z = cvt_pk_bf16(silu_f(a1[0]) * b1[0], silu_f(a1[1]) * b1[1]); w.w = cvt_pk_bf16(silu_f(a1[2]) * b1[2], silu_f(a1[3]) * b1[3]);
                *(u32x4*)rowp = w; }
    }
};
struct EpiBf16 {
    static constexpr bool PERM = true, AFTER_DRAIN = false;
    bf16_t* O; int ldc;
    __device__ __forceinline__ void operator()(const f32x4 (&acc)[2][2][4][2], const Unit& u, int wr, int wc, int fr, int fq) const {
        const int row0 = u.pm * BM + wr * 64 + fr, col0 = u.pn * BM + wc * 32 + 8 * fq;
#pragma unroll
        for (int ai = 0; ai < 2; ++ai)
#pragma unroll
            for (int m = 0; m < 4; ++m) { bf16_t* rowp = O + (size_t)(row0 + ai * HALF + m * 16) * ldc + col0;
#pragma unroll
                for (int bj = 0; bj < 2; ++bj) { const f32x4 v0 = acc[ai][bj][m][0], v1 = acc[ai][bj][m][1];
                    u32x4 w; w.x = cvt_pk_bf16(v0[0], v0[1]); w.y = cvt_pk_bf16(v0[2], v0[3]); w.z = cvt_pk_bf16(v1[0], v1[1]); w.w = cvt_pk_bf16(v1[2], v1[3]);
                    *(u32x4*)(rowp + bj * HALF) = w; } }
    }
};
struct EpiZ {
    static constexpr bool PERM = true, AFTER_DRAIN = false;
    bf16_t* Z; int ldc; float* ck; float* cv;
    __device__ __forceinline__ void operator()(const f32x4 (&acc)[2][2][4][2], const Unit& u, int wr, int wc, int fr, int fq) const {
        const int row0 = u.pm * BM + wr * 64 + fr, col0 = u.pn * BM + wc * 32 + 8 * fq;
        const bool isk = (u.pm < 32) && (u.pn >= 36) && (u.pn < 40), isv = (u.pm < 32) && (u.pn >= 40) && (u.pn < 44);
        float* cbase = isk ? ck : cv; const int csub = isk ? 9216 : 10240;
#pragma unroll
        for (int ai = 0; ai < 2; ++ai)
#pragma unroll
            for (int m = 0; m < 4; ++m) { const int r = row0 + ai * HALF + m * 16; bf16_t* rowp = Z + (size_t)r * ldc + col0;
#pragma unroll
                for (int bj = 0; bj < 2; ++bj) { const f32x4 v0 = acc[ai][bj][m][0], v1 = acc[ai][bj][m][1];
                    u32x4 w; w.x = cvt_pk_bf16(v0[0], v0[1]); w.y = cvt_pk_bf16(v0[2], v0[3]); w.z = cvt_pk_bf16(v1[0], v1[1]); w.w = cvt_pk_bf16(v1[2], v1[3]);
                    *(u32x4*)(rowp + bj * HALF) = w;
                    if (isk || isv) { float* dst = cbase + ((size_t)u.pm * 2 * 256 + (size_t)(r & 255)) * 1024 + (col0 + bj * HALF - csub);
                        *(f32x4*)dst = v0; *(f32x4*)(dst + 4) = v1; } } }
    }
};
template <int STAGE> struct EpiMerge {
    static constexpr bool PERM = true, AFTER_DRAIN = false;
    const bf16_t* Zg; int ldz; bf16_t* MB; int ldm;
    __device__ __forceinline__ void operator()(const f32x4 (&acc)[2][2][4][2], const Unit& u, int wr, int wc, int fr, int fq) const {
        const int row0 = u.pm * BM + wr * 64 + fr, col0 = u.pn * BM + wc * 32 + 8 * fq;
#pragma unroll
        for (int ai = 0; ai < 2; ++ai)
#pragma unroll
            for (int m = 0; m < 4; ++m) { const int r = row0 + ai * HALF + m * 16;
#pragma unroll
                for (int bj = 0; bj < 2; ++bj) { const int c = col0 + bj * HALF;
                    const u32x4 gw = *(const u32x4*)(Zg + (size_t)r * ldz + c);
                    f32x4 v0 = acc[ai][bj][m][0], v1 = acc[ai][bj][m][1];
                    v0[0] *= sigm_f(bf_lo(gw.x)); v0[1] *= sigm_f(bf_hi(gw.x)); v0[2] *= sigm_f(bf_lo(gw.y)); v0[3] *= sigm_f(bf_hi(gw.y));
                    v1[0] *= sigm_f(bf_lo(gw.z)); v1[1] *= sigm_f(bf_hi(gw.z)); v1[2] *= sigm_f(bf_lo(gw.w)); v1[3] *= sigm_f(bf_hi(gw.w));
                    bf16_t* mp = MB + (size_t)r * ldm + c;
                    if (STAGE > 0) { const u32x4 pw = *(const u32x4*)mp;
                        v0[0] += bf_lo(pw.x); v0[1] += bf_hi(pw.x); v0[2] += bf_lo(pw.y); v0[3] += bf_hi(pw.y); v1[0] += bf_lo(pw.z); v1[1] += bf_hi(pw.z); v1[2] += bf_lo(pw.w); v1[3] += bf_hi(pw.w); }
                    u32x4 w; w.x = cvt_pk_bf16(v0[0], v0[1]); w.y = cvt_pk_bf16(v0[2], v0[3]); w.z = cvt_pk_bf16(v1[0], v1[1]); w.w = cvt_pk_bf16(v1[2], v1[3]);
                    *(u32x4*)mp = w; } }
    }
};

template <class Epi, class Sched, bool ALIGN_EPI = false, bool SP2 = false>
__device__ __forceinline__ void gemm_phase(PG8_LAS unsigned char* lds, const Gemm g, const Sched& S, const Epi& E) {
    int tid_ = threadIdx.x; asm volatile("" : "+v"(tid_));
    const int tid = tid_, wid = __builtin_amdgcn_readfirstlane(tid >> 6), lane = tid & 63, wr = wid >> 2, wc = wid & 3, fr = lane & 15, fq = lane >> 4;
    const int K = g.K, nt = K / BK;
    unsigned voffA[2], voffB[2];
#pragma unroll
    for (int i = 0; i < 2; ++i) { int R, C; stage_rc(tid * 16 + i * 8192, R, C); const int Rb = Epi::PERM ? ((R & ~31) + perm32(R & 31)) : R;
        voffA[i] = (unsigned)(R * K + C) * 2u; voffB[i] = (unsigned)(Rb * K + C) * 2u; }
    const size_t kstep = (size_t)(BK * 2);
    const size_t hstep = (size_t)HALF * K * 2;
    const size_t tstep = 2 * hstep;
    const unsigned ldsw = (unsigned)wid * 1024u;
    const int aoff = lds_byte(wr * 64 + fr, fq * 8), boff = lds_byte(wc * 32 + fr, fq * 8);
#define PG8_SA(b, h) (((b) * 2 + (h)) * HTB)
#define PG8_SB(b, h) ((4 + (b) * 2 + (h)) * HTB)
#define PG8_STAGE(bufoff, gbase, voff) do { _Pragma("unroll") for (int _i = 0; _i < 2; ++_i) \
        __builtin_amdgcn_global_load_lds((const unsigned*)((const char*)(gbase) + (voff)[_i]), (PG8_LAS unsigned*)(lds + (bufoff) + ldsw + _i * 8192), 16, 0, 0); } while (0)
#define PG8_LDA(dst, b, h) do { _Pragma("unroll") for (int m = 0; m < 4; ++m) _Pragma("unroll") for (int k = 0; k < 2; ++k) dst[m][k] = *(const PG8_LAS bf16x8*)(lds + PG8_SA(b, h) + aoff + m * 2048 + k * 1024); } while (0)
#define PG8_LDB(dst, b, h) do { _Pragma("unroll") for (int n = 0; n < 2; ++n) _Pragma("unroll") for (int k = 0; k < 2; ++k) dst[n][k] = *(const PG8_LAS bf16x8*)(lds + PG8_SB(b, h) + boff + n * 2048 + k * 1024); } while (0)
#define PG8_MMA(ai, bj, At, Bt) do { __builtin_amdgcn_s_setprio(1); _Pragma("unroll") for (int m = 0; m < 4; ++m) _Pragma("unroll") for (int n = 0; n < 2; ++n) _Pragma("unroll") for (int k = 0; k < 2; ++k) \
        acc[ai][bj][m][n] = __builtin_amdgcn_mfma_f32_16x16x32_bf16(Bt[n][k], At[m][k], acc[ai][bj][m][n], 0, 0, 0); __builtin_amdgcn_s_setprio(0); } while (0)
#define PG8_WAIT_V(n) asm volatile("s_waitcnt vmcnt(" #n ")" ::: "memory")
#define PG8_WAIT_L(n) asm volatile("s_waitcnt lgkmcnt(" #n ")" ::: "memory")
#define PG8_BAR __builtin_amdgcn_s_barrier()
#define PG8_SCHED __builtin_amdgcn_sched_barrier(0)
    Unit cur, nxt; int ui = 0;
    if (!S.next(0, cur)) return;
    f32x4 acc[2][2][4][2];
#pragma unroll
    for (int a = 0; a < 2; ++a)
#pragma unroll
        for (int b = 0; b < 2; ++b)
#pragma unroll
            for (int m = 0; m < 4; ++m)
#pragma unroll
                for (int n = 0; n < 2; ++n) acc[a][b][m][n] = (f32x4){0.f, 0.f, 0.f, 0.f};
    bf16x8 At[4][2], B0[2][2], B1[2][2];
    const char* cA = (const char*)g.A + (size_t)cur.pm * tstep; const char* cB = (const char*)g.Bt + (size_t)cur.pn * tstep;
    S.a_ready(cur);
    if constexpr (SP2) {
        PG8_STAGE(PG8_SB(0, 0), cB, voffB); PG8_STAGE(PG8_SB(0, 1), cB + hstep, voffB); PG8_STAGE(PG8_SA(0, 0), cA, voffA); PG8_STAGE(PG8_SA(0, 1), cA + hstep, voffA);
        if (wr == 1) PG8_BAR;
        PG8_WAIT_V(2); PG8_BAR;
        PG8_STAGE(PG8_SB(1, 0), cB + kstep, voffB); PG8_STAGE(PG8_SA(1, 0), cA + kstep, voffA); PG8_STAGE(PG8_SB(1, 1), cB + hstep + kstep, voffB);
        PG8_WAIT_V(6); PG8_BAR;
    } else {
        PG8_STAGE(PG8_SB(0, 0), cB, voffB); PG8_STAGE(PG8_SA(0, 0), cA, voffA); PG8_STAGE(PG8_SB(0, 1), cB + hstep, voffB); PG8_STAGE(PG8_SA(0, 1), cA + hstep, voffA);
        if (wr == 1) PG8_BAR;
        PG8_WAIT_V(4); PG8_BAR;
        PG8_STAGE(PG8_SB(1, 0), cB + kstep, voffB); PG8_STAGE(PG8_SA(1, 0), cA + kstep, voffA); PG8_STAGE(PG8_SB(1, 1), cB + hstep + kstep, voffB);
        PG8_WAIT_V(6); PG8_BAR;
    }
    for (;;) {
        const bool has_next = S.next(ui + 1, nxt);
        const char* nA = has_next ? (const char*)g.A + (size_t)nxt.pm * tstep : cA; const char* nB = has_next ? (const char*)g.Bt + (size_t)nxt.pn * tstep : cB;
        for (int t = 0; t < nt; t += 2) {
            const bool last = (t == nt - 2);
            const char* a1 = cA + (size_t)(t + 1) * kstep;
            const char* a2 = last ? nA : cA + (size_t)(t + 2) * kstep; const char* b2 = last ? nB : cB + (size_t)(t + 2) * kstep;
            const char* a3 = a2 + kstep; const char* b3 = b2 + kstep;
            if (last && has_next) S.a_ready(nxt);
            if constexpr (SP2) {
            PG8_LDB(B0, 0, 0); PG8_LDB(B1, 0, 1); PG8_SCHED; PG8_LDA(At, 0, 0); PG8_STAGE(PG8_SA(1, 1), a1 + hstep, voffA);
            PG8_WAIT_V(8); PG8_WAIT_L(0); PG8_BAR; PG8_MMA(0, 0, At, B0); PG8_MMA(0, 1, At, B1); PG8_BAR; PG8_SCHED;
            PG8_LDA(At, 0, 1); PG8_STAGE(PG8_SB(0, 0), b2, voffB); PG8_STAGE(PG8_SB(0, 1), b2 + hstep, voffB); PG8_STAGE(PG8_SA(0, 0), a2, voffA);
            PG8_WAIT_V(8); PG8_WAIT_L(0); PG8_BAR; PG8_MMA(1, 0, At, B0); PG8_MMA(1, 1, At, B1); PG8_BAR; PG8_SCHED;
            PG8_LDB(B0, 1, 0); PG8_LDB(B1, 1, 1); PG8_SCHED; PG8_LDA(At, 1, 0); PG8_STAGE(PG8_SA(0, 1), a2 + hstep, voffA);
            PG8_WAIT_V(8); PG8_WAIT_L(0); PG8_BAR; PG8_MMA(0, 0, At, B0); PG8_MMA(0, 1, At, B1); PG8_BAR; PG8_SCHED;
            PG8_LDA(At, 1, 1); PG8_STAGE(PG8_SB(1, 0), b3, voffB); PG8_STAGE(PG8_SB(1, 1), b3 + hstep, voffB); PG8_STAGE(PG8_SA(1, 0), a3, voffA);
            PG8_WAIT_V(8); PG8_WAIT_L(0); PG8_BAR; PG8_MMA(1, 0, At, B0); PG8_MMA(1, 1, At, B1); PG8_BAR; PG8_SCHED;
            } else {
            PG8_LDB(B0, 0, 0); PG8_SCHED; PG8_LDA(At, 0, 0); PG8_STAGE(PG8_SA(1, 1), a1 + hstep, voffA);
            PG8_WAIT_L(8); PG8_BAR; PG8_WAIT_L(0); PG8_MMA(0, 0, At, B0); PG8_BAR; PG8_SCHED;
            PG8_LDB(B1, 0, 1); PG8_STAGE(PG8_SB(0, 0), b2, voffB);
            PG8_BAR; PG8_WAIT_L(0); PG8_MMA(0, 1, At, B1); PG8_BAR;
            PG8_LDA(At, 0, 1); PG8_STAGE(PG8_SA(0, 0), a2, voffA);
            PG8_BAR; PG8_WAIT_L(0); PG8_MMA(1, 0, At, B0); PG8_BAR; PG8_SCHED;
            PG8_STAGE(PG8_SB(0, 1), b2 + hstep, voffB);
            PG8_WAIT_V(6); PG8_BAR; PG8_MMA(1, 1, At, B1); PG8_BAR;
            PG8_LDB(B0, 1, 0); PG8_SCHED; PG8_LDA(At, 1, 0); PG8_STAGE(PG8_SA(0, 1), a2 + hstep, voffA);
            PG8_WAIT_L(8); PG8_BAR; PG8_WAIT_L(0); PG8_MMA(0, 0, At, B0); PG8_BAR; PG8_SCHED;
            PG8_LDB(B1, 1, 1); PG8_STAGE(PG8_SB(1, 0), b3, voffB);
            PG8_BAR; PG8_WAIT_L(0); PG8_MMA(0, 1, At, B1); PG8_BAR;
            PG8_LDA(At, 1, 1); PG8_STAGE(PG8_SA(1, 0), a3, voffA);
            PG8_BAR; PG8_WAIT_L(0); PG8_MMA(1, 0, At, B0); PG8_BAR; PG8_SCHED;
            PG8_STAGE(PG8_SB(1, 1), b3 + hstep, voffB);
            PG8_WAIT_V(6); PG8_BAR; PG8_MMA(1, 1, At, B1); PG8_BAR;
            }
        }
        if constexpr (ALIGN_EPI) { if (wr == 0) PG8_BAR; }
        if constexpr (!Epi::AFTER_DRAIN) { E(acc, cur, wr, wc, fr, fq); S.done(cur); }
        if (!has_next) break;
#pragma unroll
        for (int a = 0; a < 2; ++a)
#pragma unroll
            for (int b = 0; b < 2; ++b)
#pragma unroll
                for (int m = 0; m < 4; ++m)
#pragma unroll
                    for (int n = 0; n < 2; ++n) acc[a][b][m][n] = (f32x4){0.f, 0.f, 0.f, 0.f};
        cur = nxt; cA = nA; cB = nB; ++ui;
        if constexpr (ALIGN_EPI) { if (wr == 1) PG8_BAR; }
    }
    PG8_WAIT_V(0);
    if constexpr (!ALIGN_EPI) { if (wr == 0) PG8_BAR; }
    PG8_BAR;
    if constexpr (Epi::AFTER_DRAIN) { E.fused(acc, cur, wr, wc, fr, fq, lds, wid, lane); S.done(cur); }
#undef PG8_SA
#undef PG8_SB
#undef PG8_STAGE
#undef PG8_LDA
#undef PG8_LDB
#undef PG8_MMA
#undef PG8_WAIT_V
#undef PG8_WAIT_L
#undef PG8_BAR
#undef PG8_SCHED
}
}

constexpr int NWAVES = 8;
constexpr int D = 2048, FF = 5632, FF2 = 2 * FF, INW = 17408, NMODV = 9, NMODW = 18432;
constexpr int MC = 8192, ML = 8192, M = MC + ML;
constexpr int ZC_RQ = 0, ZC_RK = 1024, ZC_RV = 2048, ZC_RG = 4096, ZC_GU = 6144, ZC_GV = 7168, ZC_NQ = 8192, ZC_NK = 9216, ZC_NV = 10240, ZC_GA = 11264;
constexpr float NORM_EPS = 1e-6f;
constexpr float LOG2E = 1.4426950408889634f;
enum { I_XP = 0, I_XS, I_CK, I_CV, I_SR, I_C, I_CCTX, I_WADA, I_BADA, I_NPRE, I_NPOST, I_FWIN, I_FWOUT, I_WIN, I_RDL, I_GMN, I_GMWS, I_GMBS, I_RPB, I_WBR, I_WBG, I_WBN, I_WOUT, N_IN };
constexpr size_t OUT_X = 0, OUT_CK = 33554432, OUT_CV = 50331648, OUT_ST = 67108864, OUT_TOTAL = 100663296;
constexpr size_t MiB = 1u << 20;
constexpr size_t WS_CTL = 0, CTL_ZERO_BYTES = 1 * MiB;
constexpr size_t WS_ROT = 1 * MiB;
constexpr size_t WS_MOD = 2 * MiB;
constexpr size_t WS_WT = 8 * MiB;
constexpr size_t WT_UP = 0, WT_DN = 88 * MiB, WT_IN = 132 * MiB, WT_BR = 200 * MiB, WT_BG = 208 * MiB, WT_BN = 212 * MiB, WT_OUT = 216 * MiB;
constexpr size_t WS_Z = 232 * MiB;
constexpr size_t WS_Y = 776 * MiB;
constexpr size_t WS_H = 904 * MiB;
constexpr size_t WS_RET = 968 * MiB, WS_GM = 1032 * MiB, WS_NA = 1064 * MiB;
constexpr size_t WS_CKB = 1096 * MiB, WS_CVB = 1104 * MiB, WS_END = 1112 * MiB;
constexpr int CW_BAR = 4096;
constexpr int LDS_BYTES = 163840;
constexpr int MISC_OFF = 162816;

#define GAS __attribute__((address_space(1)))
#define LAS __attribute__((address_space(3)))
typedef unsigned short bf16;
typedef unsigned v4u __attribute__((ext_vector_type(4)));
typedef unsigned v2u __attribute__((ext_vector_type(2)));
typedef float f32x4 __attribute__((ext_vector_type(4)));
typedef float f32x2 __attribute__((ext_vector_type(2)));
typedef short bf16x8 __attribute__((ext_vector_type(8)));
typedef short bf16x4 __attribute__((ext_vector_type(4)));
typedef GAS unsigned gu32;
#define LDS_WAIT() asm volatile("s_waitcnt lgkmcnt(0)" ::: "memory")
#define VM_WAIT() asm volatile("s_waitcnt vmcnt(0)" ::: "memory")
__device__ __forceinline__ unsigned pk2(float lo, float hi) { return pg8::cvt_pk_bf16(lo, hi); }
__device__ __forceinline__ float bflo(unsigned w) { return __uint_as_float(w << 16); }
__device__ __forceinline__ float bfhi(unsigned w) { return __uint_as_float(w & 0xffff0000u); }
__device__ __forceinline__ float wave_sum(float v) {
#pragma unroll
    for (int o = 1; o < 64; o <<= 1) v += __shfl_xor(v, o);
    return v;
}
#define MFMA16(a, b, c) __builtin_amdgcn_mfma_f32_16x16x32_bf16((a), (b), (c), 0, 0, 0)
#define TR16(p) __builtin_amdgcn_ds_read_tr16_b64_v4i16((LAS bf16x4*)(p))
__device__ __forceinline__ bf16x8 frag_rk(const LAS bf16* base, int pitch, int row0, int k0, int lane) {
    return *(const LAS bf16x8*)(base + (row0 + (lane & 15)) * pitch + k0 + 8 * (lane >> 4));
}
__device__ __forceinline__ bf16x8 frag_ck2(const LAS bf16* base, int pitch, int rowA, int rowB, int c0, int lane) {
    const int off = (4 * (lane >> 4) + ((lane & 15) >> 2)) * pitch + c0 + 4 * (lane & 3);
    const bf16x4 lo = TR16(base + rowA * pitch + off), hi = TR16(base + rowB * pitch + off);
    return __builtin_shufflevector(lo, hi, 0, 1, 2, 3, 4, 5, 6, 7);
}
__device__ __forceinline__ bf16x8 frag_ck(const LAS bf16* base, int pitch, int k0, int c0, int lane) {
    const LAS bf16* p = base + (k0 + 8 * (lane >> 4) + ((lane & 15) >> 2)) * pitch + c0 + 4 * (lane & 3);
    const bf16x4 lo = TR16(p), hi = TR16(p + 4 * pitch);
    return __builtin_shufflevector(lo, hi, 0, 1, 2, 3, 4, 5, 6, 7);
}
#define RLX_AGENT __ATOMIC_RELAXED, __HIP_MEMORY_SCOPE_AGENT
#define XB_TMO      128
#define XB_XCNT(j)  (256  + 64 * (j))
#define XB_XSUB(j)  (1280 + 64 * (j))
#define XB_XGEN(j)  (2304 + 64 * (j))
#define XB_TOP      3328
#define XB_TOPGEN   3392
#define XCD_BAR_WORDS 3456
#define XB_SPIN_CAP (1u << 18)

__device__ __forceinline__ unsigned xb_ld(unsigned* p)              { return __hip_atomic_load(p, __ATOMIC_RELAXED, __HIP_MEMORY_SCOPE_AGENT); }
__device__ __forceinline__ unsigned xb_add(unsigned* p, unsigned v) { return __hip_atomic_fetch_add(p, v, __ATOMIC_RELAXED, __HIP_MEMORY_SCOPE_AGENT); }
__device__ __forceinline__ unsigned xb_xcc_id() { return (unsigned)__builtin_amdgcn_s_getreg((3 << 11) | 20) & 0xFu; }
#define XB_SPIN(cond, bar) do { unsigned _sp = 0; while (cond) { __builtin_amdgcn_s_sleep(1); \
    if ((++_sp & 255u) == 0u) { if (xb_ld(&(bar)[XB_TMO])) break; if (_sp > XB_SPIN_CAP) { atomicAdd(&(bar)[XB_TMO], 1u); break; } } } } while (0)

struct XcdBarrier {
    unsigned* bar; unsigned x;
    volatile LAS unsigned* st;
};

__device__ __forceinline__ XcdBarrier xcd_barrier_post(unsigned* bar, volatile LAS unsigned* st) {
    XcdBarrier b; b.bar = bar; b.x = xb_xcc_id(); b.st = st;
    if (threadIdx.x == 0) (void)xb_add(&bar[XB_XCNT(b.x)], 1u);
    return b;
}
__device__ __forceinline__ void xcd_barrier_complete(unsigned* bar, unsigned x, unsigned& nloc, unsigned& nx) {
    const unsigned G = gridDim.x * gridDim.y * gridDim.z;
    unsigned sum, cnt, mine, sp = 0u;
    for (;;) {
        sum = 0u; cnt = 0u; mine = 0u;
#pragma unroll
        for (unsigned j = 0; j < 16; ++j) { const unsigned c = xb_ld(&bar[XB_XCNT(j)]); sum += c; cnt += (c > 0u) ? 1u : 0u; mine = (j == x) ? c : mine; }
        if (sum == G) break;
        __builtin_amdgcn_s_sleep(1);
        if ((++sp & 255u) == 0u) { if (xb_ld(&bar[XB_TMO])) break; if (sp > XB_SPIN_CAP) { atomicAdd(&bar[XB_TMO], 1u); break; } }
    }
    nloc = mine > 0u ? mine : 1u; nx = cnt > 0u ? cnt : 1u;
}

__device__ __forceinline__ void xcd_barrier(const XcdBarrier& b) {
    asm volatile("s_waitcnt vmcnt(0)" ::: "memory");
    __syncthreads();
    if (threadIdx.x == 0) {
        unsigned* bar = b.bar;
        __builtin_amdgcn_s_waitcnt(0);
        unsigned nloc = b.st[0], nx = b.st[1];
        if (nloc == 0u) { xcd_barrier_complete(bar, b.x, nloc, nx); b.st[0] = nloc; b.st[1] = nx; }
        const unsigned old = xb_add(&bar[XB_XSUB(b.x)], 1u);
        const unsigned gen = old / nloc;
        if (old + 1u == (gen + 1u) * nloc) {
            __builtin_amdgcn_fence(__ATOMIC_RELEASE, "agent");
            asm volatile("s_waitcnt vmcnt(0)" ::: "memory");
            const unsigned og = xb_add(&bar[XB_TOP], 1u);
            const unsigned tg = og / nx;
            if (og + 1u == (tg + 1u) * nx) xb_add(&bar[XB_TOPGEN], 1u);
            else XB_SPIN(xb_ld(&bar[XB_TOPGEN]) == tg, bar);
            __builtin_amdgcn_fence(__ATOMIC_ACQUIRE, "agent");
            xb_add(&bar[XB_XGEN(b.x)], 1u);
            asm volatile("s_waitcnt vmcnt(0)" ::: "memory");
        } else {
            XB_SPIN(xb_ld(&bar[XB_XGEN(b.x)]) == gen, bar);
            __builtin_amdgcn_fence(__ATOMIC_ACQUIRE, "agent");
            asm volatile("s_waitcnt vmcnt(0)" ::: "memory");
        }
    }
    __syncthreads();
}

struct Args { const float* in[N_IN]; float* out; unsigned char* ws; int ph_lo, ph_hi; };
__device__ __forceinline__ const float* inp(int i) { const float* const __attribute__((address_space(4)))* kp = (const float* const __attribute__((address_space(4)))*)__builtin_amdgcn_kernarg_segment_ptr(); asm volatile("" : "+s"(kp)); return kp[i]; }

__device__ __forceinline__ unsigned char* wsp(const Args& a) { unsigned char* p = a.ws; asm volatile("" : "+s"(p)); return p; }
__device__ __forceinline__ float* outp(const Args& a) { float* p = a.out; asm volatile("" : "+s"(p)); return p; }
__device__ __forceinline__ int up_destrow(int n) { const int half = n >= FF ? 1 : 0; const int j = n - half * FF; return (j >> 7) * 256 + half * 128 + (j & 127); }
template <bool SWI> __device__ __forceinline__ void transpose_item(const float* __restrict__ W, int K, int N, bf16* __restrict__ WT, LAS float* scr, int item, int lane) {
    const int nblk = N / 64, kb = item / nblk, nb = item - kb * nblk, k0 = 64 * kb, n0 = 64 * nb;
    const int kr = lane >> 4, q = lane & 15;
    const float* src = W + (size_t)(k0 + kr) * N + n0 + 4 * q;
    f32x4 v[16];
#pragma unroll
    for (int i = 0; i < 16; ++i) v[i] = *(const f32x4*)(src + (size_t)(4 * i) * N);
#pragma unroll
    for (int i = 0; i < 16; ++i) { const int k = 4 * i + kr; *(LAS f32x4*)(scr + k * 64 + 4 * (q ^ ((k >> 3) & 7))) = v[i]; }
    LDS_WAIT(); asm volatile("" ::: "memory");
    const int r0 = SWI ? up_destrow(n0) : n0;
    const int c = lane & 7;
#pragma unroll
    for (int j = 0; j < 8; ++j) { const int n = (lane >> 3) + 8 * j; const LAS float* s = scr + (8 * c) * 64 + 4 * ((n >> 2) ^ c) + (n & 3);
        v4u o; o.x = pk2(s[0 * 64], s[1 * 64]); o.y = pk2(s[2 * 64], s[3 * 64]); o.z = pk2(s[4 * 64], s[5 * 64]); o.w = pk2(s[6 * 64], s[7 * 64]);
        *(v4u*)(WT + (size_t)(r0 + n) * K + k0 + 8 * c) = o; }
    LDS_WAIT(); asm volatile("" ::: "memory");
}
__device__ __forceinline__ void conv_phase(const Args& a, const int l, LAS unsigned char* lds, const int vcu, const int G) {
    int tid = threadIdx.x; asm volatile("" : "+v"(tid)); const int lane = tid & 63, wave = __builtin_amdgcn_readfirstlane(tid >> 6);
    unsigned char* ws = wsp(a);
    __syncthreads();
    if (l == 0) {
        { const int gt = vcu * 512 + tid; if (gt < 64 * 32) { const int pos = gt >> 5, f = gt & 31; const float inv = powf(10000.0f, -(float)(2 * f) / 64.0f); const float ang = (float)pos * inv;
            float s, c; sincosf(ang, &s, &c); ((f32x2*)(ws + WS_ROT))[gt] = (f32x2){c, s}; } }
        { const int gt = vcu * 512 + tid, NT = G * 512;
          for (int c = gt; c < 2 * 524288; c += NT) { const int which = c >= 524288 ? 1 : 0; const size_t e = (size_t)(c - which * 524288) * 8;
              const float* src = (which ? inp(I_CV) : inp(I_CK)) + e; const f32x4 v0 = *(const f32x4*)src, v1 = *(const f32x4*)(src + 4);
              v4u o; o.x = pk2(v0[0], v0[1]); o.y = pk2(v0[2], v0[3]); o.z = pk2(v1[0], v1[1]); o.w = pk2(v1[2], v1[3]);
              *(v4u*)((bf16*)(ws + (which ? WS_CVB : WS_CKB)) + e) = o; } }
        LAS float* sc = (LAS float*)lds;
        LAS float* red = (LAS float*)(lds + 73728);
        for (int idx = tid; idx < NMODV * D; idx += 512) { const int v = idx >> 11, k = idx & 2047; const float x = (v == 0) ? inp(I_CCTX)[k] : inp(I_C)[(v - 1) * D + k]; sc[idx] = x / (1.0f + expf(-x)); }
        __syncthreads();
        float* MOD = (float*)(ws + WS_MOD);
        const int half = lane >> 5, ln = lane & 31;
        for (int u = vcu; u < 288; u += G) {
            const int la = u / 144, n0 = (u - la * 144) * 128;
            const float* W = inp(I_WADA) + (size_t)la * D * NMODW + n0 + 4 * ln;
            f32x4 acc[NMODV];
#pragma unroll
            for (int v = 0; v < NMODV; ++v) acc[v] = (f32x4){0.f, 0.f, 0.f, 0.f};
#pragma unroll 8
            for (int kk = 0; kk < 128; ++kk) { const int k = wave * 256 + 2 * kk + half; const f32x4 w = *(const f32x4*)(W + (size_t)k * NMODW);
#pragma unroll
                for (int v = 0; v < NMODV; ++v) { const float s = sc[v * D + k]; acc[v] += w * s; } }
#pragma unroll
            for (int v = 0; v < NMODV; ++v) {
#pragma unroll
                for (int j = 0; j < 4; ++j) acc[v][j] += __shfl_xor(acc[v][j], 32);
                if (half == 0) *(LAS f32x4*)(red + (wave * NMODV + v) * 128 + 4 * ln) = acc[v]; }
            __syncthreads();
            for (int o = tid; o < NMODV * 128; o += 512) { const int v = o >> 7, n = o & 127; float s = 0.f;
#pragma unroll
                for (int w = 0; w < 8; ++w) s += red[(w * NMODV + v) * 128 + n];
                MOD[(size_t)(la * NMODV + v) * NMODW + n0 + n] = s + inp(I_BADA)[la * NMODW + n0 + n]; }
            __syncthreads();
        }
    }
    LAS float* scr = (LAS float*)(lds + wave * 16384);
    const int gw = vcu * NWAVES + wave, NGW = G * NWAVES;
    constexpr int I_UP = 32 * 176, I_DN = 88 * 32, I_INW = 32 * 272, I_BRW = 32 * 32, I_BGW = 16 * 32;
    constexpr int NITEMS = 2 * I_UP + 2 * I_DN + I_INW + 2 * I_BRW + 2 * I_BGW;
    bf16* WT = (bf16*)(ws + WS_WT);
    for (int it = gw; it < NITEMS; it += NGW) {
        int r = it;
        if (r < 2 * I_UP) { const int s = r >= I_UP ? 1 : 0; r -= s * I_UP; transpose_item<true>(inp(I_FWIN) + (size_t)(l * 2 + s) * D * FF2, D, FF2, (bf16*)(ws + WS_WT + WT_UP + s * 44 * MiB), scr, r, lane); continue; } r -= 2 * I_UP;
        if (r < 2 * I_DN) { const int s = r >= I_DN ? 1 : 0; r -= s * I_DN; transpose_item<false>(inp(I_FWOUT) + (size_t)(l * 2 + s) * FF * D, FF, D, (bf16*)(ws + WS_WT + WT_DN + s * 22 * MiB), scr, r, lane); continue; } r -= 2 * I_DN;
        if (r < I_INW) { transpose_item<false>(inp(I_WIN) + (size_t)l * D * INW, D, INW, (bf16*)(ws + WS_WT + WT_IN), scr, r, lane); continue; } r -= I_INW;
        if (r < I_BRW) { transpose_item<false>(inp(I_WBR) + (size_t)l * D * D, D, D, (bf16*)(ws + WS_WT + WT_BR), scr, r, lane); continue; } r -= I_BRW;
        if (r < I_BGW) { transpose_item<false>(inp(I_WBG) + (size_t)l * 1024 * D, 1024, D, (bf16*)(ws + WS_WT + WT_BG), scr, r, lane); continue; } r -= I_BGW;
        if (r < I_BGW) { transpose_item<false>(inp(I_WBN) + (size_t)l * 1024 * D, 1024, D, (bf16*)(ws + WS_WT + WT_BN), scr, r, lane); continue; } r -= I_BGW;
        transpose_item<false>(inp(I_WOUT) + (size_t)l * D * D, D, D, (bf16*)(ws + WS_WT + WT_OUT), scr, r, lane);
    }
    (void)WT;
}

template <bool INIT, bool UPD, bool NXT>
__device__ __forceinline__ void thin_phase(const Args& a, const int lu, const int iu, const float res_w, const int ln_, const int in_, const int vcu, const int G) {
    int tid = threadIdx.x; asm volatile("" : "+v"(tid)); const int lane = tid & 63, wave = __builtin_amdgcn_readfirstlane(tid >> 6);
    const float* MOD = (const float*)(wsp(a) + WS_MOD);
    float* X = outp(a) + OUT_X; const bf16* Y = (const bf16*)(wsp(a) + WS_Y); bf16* H = (bf16*)(wsp(a) + WS_H);
    const int gw = vcu * NWAVES + wave, NGW = G * NWAVES;
    for (int blk = gw; blk < M / 8; blk += NGW) {
        const int row0 = blk * 8; const int midx = row0 < MC ? 0 : 1 + ((row0 - MC) >> 10);
        f32x4 ca[8], cb[8], cc[8];
        if (UPD) { const float* gate = MOD + (size_t)(lu * NMODV + midx) * NMODW + (3 * iu + 2) * D; const float* gp = inp(I_NPOST) + (size_t)(lu * 3 + iu) * D;
#pragma unroll
            for (int j = 0; j < 8; ++j) { const int c = 4 * lane + 256 * j; ca[j] = *(const f32x4*)(gate + c) * *(const f32x4*)(gp + c) * res_w; } }
        if (NXT) { const float* sh = MOD + (size_t)(ln_ * NMODV + midx) * NMODW + (3 * in_ + 0) * D; const float* scl = sh + D; const float* gpre = inp(I_NPRE) + (size_t)(ln_ * 3 + in_) * D;
#pragma unroll
            for (int j = 0; j < 8; ++j) { const int c = 4 * lane + 256 * j; cb[j] = *(const f32x4*)(gpre + c) * (*(const f32x4*)(scl + c) + 1.0f); cc[j] = *(const f32x4*)(sh + c); } }
        for (int rr = 0; rr < 8; ++rr) {
            const int row = row0 + rr;
            const float* xin = INIT ? (row < MC ? inp(I_XP) + (size_t)row * D : inp(I_XS) + (size_t)(row - MC) * D) : X + (size_t)row * D;
            f32x4 x[8];
#pragma unroll
            for (int j = 0; j < 8; ++j) x[j] = *(const f32x4*)(xin + 4 * lane + 256 * j);
            if (UPD) { f32x4 y[8]; float ss = 0.f;
#pragma unroll
                for (int j = 0; j < 8; ++j) { const v2u yw = *(const v2u*)(Y + (size_t)row * D + 4 * lane + 256 * j); y[j] = (f32x4){bflo(yw.x), bfhi(yw.x), bflo(yw.y), bfhi(yw.y)}; ss += (y[j][0] * y[j][0] + y[j][1] * y[j][1]) + (y[j][2] * y[j][2] + y[j][3] * y[j][3]); }
                const float rstd = 1.0f / sqrtf(wave_sum(ss) * (1.0f / D) + NORM_EPS);
#pragma unroll
                for (int j = 0; j < 8; ++j) x[j] += ca[j] * (y[j] * rstd); }
            if (UPD || INIT) {
#pragma unroll
                for (int j = 0; j < 8; ++j) *(f32x4*)(X + (size_t)row * D + 4 * lane + 256 * j) = x[j]; }
            if (NXT) { float ss = 0.f;
#pragma unroll
                for (int j = 0; j < 8; ++j) ss += (x[j][0] * x[j][0] + x[j][1] * x[j][1]) + (x[j][2] * x[j][2] + x[j][3] * x[j][3]);
                const float rstd = 1.0f / sqrtf(wave_sum(ss) * (1.0f / D) + NORM_EPS);
#pragma unroll
                for (int j = 0; j < 8; ++j) { const f32x4 h = (x[j] * rstd) * cb[j] + cc[j]; v2u w; w.x = pk2(h[0], h[1]); w.y = pk2(h[2], h[3]);
                    *(v2u*)(H + (size_t)row * D + 4 * lane + 256 * j) = w; } }
        }
    }
}

constexpr int PK = 136, PV = 264;
__device__ __forceinline__ float log_decay(const Args& a, int l, int dir, int h) { const float x = inp(I_RDL)[(l * 2 + dir) * 8 + h]; return -log1pf(expf(-x)); }

struct QKRaw { v4u w1[2], w2[2]; };
__device__ __forceinline__ f32x4 rot_ld(const float* p) { return *(const f32x4*)p; }
__device__ __forceinline__ f32x4 rot_ld(const LAS float* p) { return *(const LAS f32x4*)p; }
__device__ __forceinline__ void qk_load(QKRaw& r, const bf16* Z, const size_t tok0, const int col0, const int tid) {
#pragma unroll
    for (int it = 0; it < 2; ++it) { const int item = tid + 512 * it; const int j = item >> 3, c1 = 64 * ((item >> 2) & 1) + 8 * (item & 3);
        const bf16* src = Z + (tok0 + j) * INW + col0; r.w1[it] = *(const v4u*)(src + c1); r.w2[it] = *(const v4u*)(src + c1 + 32); }
}
template <int WMODE, class ROTP>
__device__ __forceinline__ void qk_write(LAS bf16* dst, const QKRaw& r, const ROTP ROT, const bool rotary, const int t0, const float wscale, const float lgw, const int tid) {
#pragma unroll
    for (int it = 0; it < 2; ++it) {
        const int item = tid + 512 * it;
        const int j = item >> 3, hf = (item >> 2) & 1, u = item & 3;
        const int c1 = 64 * hf + 8 * u, c2 = c1 + 32;
        const v4u w1 = r.w1[it], w2 = r.w2[it];
        float x1[8], x2[8];
        x1[0] = bflo(w1.x); x1[1] = bfhi(w1.x); x1[2] = bflo(w1.y); x1[3] = bfhi(w1.y); x1[4] = bflo(w1.z); x1[5] = bfhi(w1.z); x1[6] = bflo(w1.w); x1[7] = bfhi(w1.w);
        x2[0] = bflo(w2.x); x2[1] = bfhi(w2.x); x2[2] = bflo(w2.y); x2[3] = bfhi(w2.y); x2[4] = bflo(w2.z); x2[5] = bfhi(w2.z); x2[6] = bflo(w2.w); x2[7] = bfhi(w2.w);
        float wj = wscale;
        if (WMODE == 1) wj *= expf(lgw * (float)(127 - j));
        if (WMODE == 2) wj *= expf(lgw * (float)j);
        float o1[8], o2[8];
        if (rotary) { const int t = t0 + j; const int pos = hf == 0 ? (t >> 6) : (t & 63);
#pragma unroll
            for (int e2 = 0; e2 < 4; ++e2) { const f32x4 cs = rot_ld(ROT + (pos * 32 + 8 * u) * 2 + 4 * e2);
                o1[2 * e2] = (x1[2 * e2] * cs[0] - x2[2 * e2] * cs[1]) * wj; o2[2 * e2] = (x1[2 * e2] * cs[1] + x2[2 * e2] * cs[0]) * wj;
                o1[2 * e2 + 1] = (x1[2 * e2 + 1] * cs[2] - x2[2 * e2 + 1] * cs[3]) * wj; o2[2 * e2 + 1] = (x1[2 * e2 + 1] * cs[3] + x2[2 * e2 + 1] * cs[2]) * wj; } }
        else {
#pragma unroll
            for (int e = 0; e < 8; ++e) { o1[e] = x1[e] * wj; o2[e] = x2[e] * wj; } }
        v4u p1, p2; p1.x = pk2(o1[0], o1[1]); p1.y = pk2(o1[2], o1[3]); p1.z = pk2(o1[4], o1[5]); p1.w = pk2(o1[6], o1[7]);
        p2.x = pk2(o2[0], o2[1]); p2.y = pk2(o2[2], o2[3]); p2.z = pk2(o2[4], o2[5]); p2.w = pk2(o2[6], o2[7]);
        *(LAS v4u*)(dst + j * PK + c1) = p1; *(LAS v4u*)(dst + j * PK + c2) = p2;
    }
}
template <int WMODE>
__device__ __forceinline__ void stage_qk(LAS bf16* dst, const bf16* Z, const float* ROT, const size_t tok0, const int col0, const bool rotary, const int t0, const float wscale, const float lgw, const int tid) {
    QKRaw r; qk_load(r, Z, tok0, col0, tid); qk_write<WMODE>(dst, r, ROT, rotary, t0, wscale, lgw, tid);
}
template <int ROWS, int COLS> __device__ __forceinline__ void stage_copy(LAS bf16* dst, const int pitch, const bf16* src, const size_t ld, const int t, const int nt) {
    constexpr int CPR = COLS / 8;
    for (int c = t; c < ROWS * CPR; c += nt) { const int r = c / CPR, cc = c - r * CPR; *(LAS v4u*)(dst + r * pitch + 8 * cc) = *(const v4u*)(src + (size_t)r * ld + 8 * cc); }
}

__device__ __forceinline__ size_t st_index(int grp, int b, int h, int n, int dir) { return grp ? (size_t)1024 + ((size_t)((b * 8 + h) * 8 + n)) * 2 + dir : ((size_t)((b * 8 + h) * 2 + n)) * 2 + dir; }
__device__ __forceinline__ void ret_chain(const Args& a, const int l, LAS unsigned char* lds, const int grp, const int b, const int h, const int dir) {
    int tid = threadIdx.x; asm volatile("" : "+v"(tid)); const int lane = tid & 63, wave = __builtin_amdgcn_readfirstlane(tid >> 6);
    const bf16* Z = (const bf16*)(wsp(a) + WS_Z); const float* ROT = (const float*)(wsp(a) + WS_ROT); bf16* ST = (bf16*)(wsp(a) + WS_Y);
    const int NCH = grp ? 8 : 2; const size_t rowbase = grp ? (size_t)MC + (size_t)b * 1024 : (size_t)b * 256;
    LAS bf16* Kw = (LAS bf16*)lds; LAS bf16* Vs = Kw + 128 * PK;
    const float lg = log_decay(a, l, dir, h); const float gch = expf(lg * 128.0f);
    const int g4 = 4 * (lane >> 4), li = lane & 15;
    f32x4 acc[8][2];
    if (grp) { const float* s0 = inp(I_SR) + ((size_t)(((b * 2 + l) * 2 + dir) * 8 + h)) * 128 * 256; const unsigned loff = (unsigned)(g4 * 256 + 32 * wave + li);
#pragma unroll
        for (int mt = 0; mt < 8; ++mt) { const float* pb = s0 + 16 * 256 * mt;
#pragma unroll
            for (int nt = 0; nt < 2; ++nt)
#pragma unroll
                for (int r = 0; r < 4; ++r) acc[mt][nt][r] = pb[loff + (unsigned)(r * 256 + 16 * nt)]; } }
    else {
#pragma unroll
        for (int mt = 0; mt < 8; ++mt)
#pragma unroll
            for (int nt = 0; nt < 2; ++nt) acc[mt][nt] = (f32x4){0.f, 0.f, 0.f, 0.f}; }
    LAS float* ROTL = (LAS float*)(Vs + 128 * PV);
    __syncthreads();
    if (grp) { for (int c = tid; c < 1024; c += 512) *(LAS f32x4*)(ROTL + 4 * c) = *(const f32x4*)(ROT + 4 * c); }
    QKRaw kr; v4u vr[8];
    { const int n0 = dir ? NCH - 1 : 0; qk_load(kr, Z, rowbase + (size_t)n0 * 128, ZC_RK + h * 128, tid);
      const bf16* vsrc = Z + (rowbase + (size_t)n0 * 128) * INW + ZC_RV + h * 256;
#pragma unroll
      for (int i = 0; i < 8; ++i) { const int c = tid + 512 * i; vr[i] = *(const v4u*)(vsrc + (size_t)(c >> 5) * INW + 8 * (c & 31)); } }
    for (int step = 0; step < NCH; ++step) {
        const int n = dir ? NCH - 1 - step : step;
        __syncthreads();
        int tl = tid; asm volatile("" : "+v"(tl));
        if (dir == 0) qk_write<1>(Kw, kr, (const LAS float*)ROTL, grp != 0, n * 128, 0.08838834764831845f, lg, tl);
        else          qk_write<2>(Kw, kr, (const LAS float*)ROTL, grp != 0, n * 128, 0.08838834764831845f, lg, tl);
#pragma unroll
        for (int i = 0; i < 8; ++i) { const int c = tl + 512 * i; *(LAS v4u*)(Vs + (c >> 5) * PV + 8 * (c & 31)) = vr[i]; }
        bf16* st = ST + st_index(grp, b, h, n, dir) * 32768;
#pragma unroll
        for (int mt = 0; mt < 8; ++mt)
#pragma unroll
            for (int nt = 0; nt < 2; ++nt) { v2u w; w.x = pk2(acc[mt][nt][0], acc[mt][nt][1]); w.y = pk2(acc[mt][nt][2], acc[mt][nt][3]);
                *(v2u*)(st + (size_t)(32 * wave + 16 * nt + li) * 128 + 16 * mt + g4) = w; acc[mt][nt] *= gch; }
        __syncthreads();
        if (step + 1 < NCH) { const int n1 = dir ? n - 1 : n + 1;
            qk_load(kr, Z, rowbase + (size_t)n1 * 128, ZC_RK + h * 128, tl);
            const bf16* vsrc = Z + (rowbase + (size_t)n1 * 128) * INW + ZC_RV + h * 256;
#pragma unroll
            for (int i = 0; i < 8; ++i) { const int c = tl + 512 * i; vr[i] = *(const v4u*)(vsrc + (size_t)(c >> 5) * INW + 8 * (c & 31)); } }
#pragma unroll 1
        for (int ks = 0; ks < 4; ++ks) { bf16x8 bv[2];
#pragma unroll
            for (int nt = 0; nt < 2; ++nt) bv[nt] = frag_ck(Vs, PV, 32 * ks, 32 * wave + 16 * nt, lane);
#pragma unroll
            for (int mt = 0; mt < 8; ++mt) { const bf16x8 ak = frag_ck(Kw, PK, 32 * ks, 16 * mt, lane);
#pragma unroll
                for (int nt = 0; nt < 2; ++nt) acc[mt][nt] = MFMA16(ak, bv[nt], acc[mt][nt]);
                if (mt & 1) __builtin_amdgcn_sched_barrier(0); } }
    }
    if (!grp) { float* s0 = outp(a) + OUT_ST + ((size_t)(((b * 2 + l) * 2 + dir) * 8 + h)) * 128 * 256; const unsigned loff = (unsigned)(g4 * 256 + 32 * wave + li);
#pragma unroll
        for (int mt = 0; mt < 8; ++mt) { float* pb = s0 + 16 * 256 * mt;
#pragma unroll
            for (int nt = 0; nt < 2; ++nt)
#pragma unroll
                for (int r = 0; r < 4; ++r) pb[loff + (unsigned)(r * 256 + 16 * nt)] = acc[mt][nt][r]; } }
}

__device__ __forceinline__ void ret_out_rot(const Args& a, LAS unsigned char* lds) {
    int tid = threadIdx.x; asm volatile("" : "+v"(tid));
    const float* ROT = (const float*)(wsp(a) + WS_ROT); LAS float* ROTL = (LAS float*)(lds + 2 * (2 * 128 * PK + 128 * PV)) + 1024;
    __syncthreads();
    for (int c = tid; c < 1024; c += 512) *(LAS f32x4*)(ROTL + 4 * c) = *(const f32x4*)(ROT + 4 * c);
}
__device__ __forceinline__ void ret_out_unit(const Args& a, const int l, LAS unsigned char* lds, const int grp, const int b, const int h, const int n) {
    int tid = threadIdx.x; asm volatile("" : "+v"(tid)); const int lane = tid & 63, wave = __builtin_amdgcn_readfirstlane(tid >> 6);
    const bf16* Z = (const bf16*)(wsp(a) + WS_Z); const float* ROT = (const float*)(wsp(a) + WS_ROT); const bf16* ST = (const bf16*)(wsp(a) + WS_Y); bf16* RET = (bf16*)(wsp(a) + WS_RET);
    const size_t tok0 = (grp ? (size_t)MC + (size_t)b * 1024 : (size_t)b * 256) + (size_t)n * 128;
    LAS bf16* Qs = (LAS bf16*)lds; LAS bf16* KP = Qs + 128 * PK; LAS bf16* Vs = KP + 128 * PK; LAS float* RED = (LAS float*)(Vs + 128 * PV); LAS float* ROTL = RED + 1024;
    const float l2f = log_decay(a, l, 0, h) * LOG2E, l2b = log_decay(a, l, 1, h) * LOG2E;
    const int g4 = 4 * (lane >> 4), li = lane & 15;
    __syncthreads();
    bf16x8 af0[4][2], af1[4][2];
    { const bf16* st = ST + st_index(grp, b, h, n, 0) * 32768 + (size_t)(32 * wave + li) * 128 + 2 * g4;
#pragma unroll
        for (int ks = 0; ks < 4; ++ks)
#pragma unroll
            for (int mt = 0; mt < 2; ++mt) af0[ks][mt] = *(const bf16x8*)(st + (size_t)(16 * mt) * 128 + 32 * ks); }
    { QKRaw qr, kr; v4u vr[8];
      qk_load(qr, Z, tok0, ZC_RQ + h * 128, tid); qk_load(kr, Z, tok0, ZC_RK + h * 128, tid);
      const bf16* vsrc = Z + tok0 * INW + ZC_RV + h * 256;
#pragma unroll
      for (int i = 0; i < 8; ++i) { const int c = tid + 512 * i; vr[i] = *(const v4u*)(vsrc + (size_t)(c >> 5) * INW + 8 * (c & 31)); }
      qk_write<0>(Qs, qr, (const LAS float*)ROTL, grp != 0, n * 128, 1.0f, 0.f, tid);
      qk_write<0>(KP, kr, (const LAS float*)ROTL, grp != 0, n * 128, 0.08838834764831845f, 0.f, tid);
#pragma unroll
      for (int i = 0; i < 8; ++i) { const int c = tid + 512 * i; *(LAS v4u*)(Vs + (c >> 5) * PV + 8 * (c & 31)) = vr[i]; } }
    __syncthreads();
    { f32x4 s[8];
#pragma unroll
        for (int mt = 0; mt < 8; ++mt) s[mt] = (f32x4){0.f, 0.f, 0.f, 0.f};
#pragma unroll 1
        for (int ks = 0; ks < 4; ++ks) { const bf16x8 bq = frag_rk(Qs, PK, 16 * wave, 32 * ks, lane);
#pragma unroll
            for (int mt = 0; mt < 8; ++mt) s[mt] = MFMA16(frag_rk(KP, PK, 16 * mt, 32 * ks, lane), bq, s[mt]); }
        const int i = 16 * wave + li;
        __syncthreads();
#pragma unroll
        for (int mt = 0; mt < 8; ++mt) { float pv[4];
#pragma unroll
            for (int r = 0; r < 4; ++r) { const int j = 16 * mt + g4 + r; const float dij = (float)(i - j);
                const float w = (dij >= 0.f ? __builtin_amdgcn_exp2f(l2f * dij) : 0.f) + (dij <= 0.f ? __builtin_amdgcn_exp2f(-l2b * dij) : 0.f); pv[r] = s[mt][r] * w; }
            v2u w2; w2.x = pk2(pv[0], pv[1]); w2.y = pk2(pv[2], pv[3]); *(LAS v2u*)(KP + i * PK + 16 * mt + g4) = w2; }
    }
    __syncthreads();
    f32x4 o[2][8];
#pragma unroll
    for (int mt = 0; mt < 2; ++mt)
#pragma unroll
        for (int nt = 0; nt < 8; ++nt) o[mt][nt] = (f32x4){0.f, 0.f, 0.f, 0.f};
    { const bf16* st = ST + st_index(grp, b, h, n, 1) * 32768 + (size_t)(32 * wave + li) * 128 + 2 * g4;
#pragma unroll
        for (int ks = 0; ks < 4; ++ks)
#pragma unroll
            for (int mt = 0; mt < 2; ++mt) af1[ks][mt] = *(const bf16x8*)(st + (size_t)(16 * mt) * 128 + 32 * ks); }
#pragma unroll
    for (int ks = 0; ks < 4; ++ks) {
#pragma unroll
        for (int nt = 0; nt < 8; ++nt) { const bf16x8 bq = frag_rk(Qs, PK, 16 * nt, 32 * ks, lane);
#pragma unroll
            for (int mt = 0; mt < 2; ++mt) o[mt][nt] = MFMA16(af0[ks][mt], bq, o[mt][nt]); }
        __builtin_amdgcn_sched_barrier(0); }
#pragma unroll
    for (int nt = 0; nt < 8; ++nt) { const float fi = (float)(16 * nt + li); const float sc = __builtin_amdgcn_exp2f(l2f * (fi + 1.0f) - l2b * (128.0f - fi));
#pragma unroll
        for (int mt = 0; mt < 2; ++mt) o[mt][nt] *= sc; }
#pragma unroll
    for (int ks = 0; ks < 4; ++ks) {
#pragma unroll
        for (int nt = 0; nt < 8; ++nt) { const bf16x8 bq = frag_rk(Qs, PK, 16 * nt, 32 * ks, lane);
#pragma unroll
            for (int mt = 0; mt < 2; ++mt) o[mt][nt] = MFMA16(af1[ks][mt], bq, o[mt][nt]); }
        __builtin_amdgcn_sched_barrier(0); }
#pragma unroll
    for (int nt = 0; nt < 8; ++nt) { const float fi = (float)(16 * nt + li); const float sc = __builtin_amdgcn_exp2f(l2b * (128.0f - fi));
#pragma unroll
        for (int mt = 0; mt < 2; ++mt) o[mt][nt] *= sc; }
#pragma unroll 1
    for (int ks = 0; ks < 4; ++ks) { bf16x8 av[2];
#pragma unroll
        for (int mt = 0; mt < 2; ++mt) av[mt] = frag_ck(Vs, PV, 32 * ks, 32 * wave + 16 * mt, lane);
#pragma unroll
        for (int nt = 0; nt < 8; ++nt) { const bf16x8 bp = frag_rk(KP, PK, 16 * nt, 32 * ks, lane);
#pragma unroll
            for (int mt = 0; mt < 2; ++mt) o[mt][nt] = MFMA16(av[mt], bp, o[mt][nt]); } }
#pragma unroll
    for (int nt = 0; nt < 8; ++nt) { float ss = 0.f;
#pragma unroll
        for (int mt = 0; mt < 2; ++mt) ss += (o[mt][nt][0] * o[mt][nt][0] + o[mt][nt][1] * o[mt][nt][1]) + (o[mt][nt][2] * o[mt][nt][2] + o[mt][nt][3] * o[mt][nt][3]);
        ss += __shfl_xor(ss, 16); ss += __shfl_xor(ss, 32);
        if (lane < 16) RED[wave * 128 + 16 * nt + lane] = ss; }
    __syncthreads();
#pragma unroll
    for (int nt = 0; nt < 8; ++nt) { const int i = 16 * nt + li; float tot = 0.f;
#pragma unroll
        for (int w = 0; w < 8; ++w) tot += RED[w * 128 + i];
        const float rstd = 1.0f / sqrtf(tot * (1.0f / 256.0f) + NORM_EPS);
        const bf16* gp = Z + (tok0 + i) * INW + ZC_RG + h * 256 + 32 * wave + g4; bf16* op = RET + (tok0 + i) * D + h * 256 + 32 * wave + g4;
#pragma unroll
        for (int mt = 0; mt < 2; ++mt) { const v2u gw = *(const v2u*)(gp + 16 * mt); const f32x4 v = o[mt][nt] * rstd;
            v2u w; w.x = pk2(v[0] * pg8::silu_f(bflo(gw.x)), v[1] * pg8::silu_f(bfhi(gw.x))); w.y = pk2(v[2] * pg8::silu_f(bflo(gw.y)), v[3] * pg8::silu_f(bfhi(gw.y)));
            *(v2u*)(op + 16 * mt) = w; } }
}

__device__ __forceinline__ void gmlp_unit(const Args& a, const int l, LAS unsigned char* lds, const int grp, const int b, const int n, const int g) {
    int tid = threadIdx.x; asm volatile("" : "+v"(tid)); const int lane = tid & 63, wave = __builtin_amdgcn_readfirstlane(tid >> 6);
    const bf16* Z = (const bf16*)(wsp(a) + WS_Z); bf16* GMo = (bf16*)(wsp(a) + WS_GM);
    const size_t tok0 = (grp ? (size_t)MC + (size_t)b * 1024 : (size_t)b * 256) + (size_t)n * 128;
    LAS bf16* VN = (LAS bf16*)lds; LAS bf16* WS = VN + 128 * PV; LAS f32x2* STAT = (LAS f32x2*)(WS + 128 * PK);
    const int g4 = 4 * (lane >> 4), li = lane & 15;
    __syncthreads();
    v4u vraw[8]; f32x4 wraw[8];
#pragma unroll
    for (int i = 0; i < 8; ++i) { const int c = tid + 512 * i; vraw[i] = *(const v4u*)(Z + (tok0 + (c >> 5)) * INW + ZC_GV + g * 256 + 8 * (c & 31)); }
    { const float* wsrc = inp(I_GMWS) + (size_t)(l * 4 + g) * 128 * 128;
#pragma unroll
      for (int i = 0; i < 8; ++i) { const int c = tid + 512 * i; wraw[i] = *(const f32x4*)(wsrc + (c >> 5) * 128 + 4 * (c & 31)); } }
#pragma unroll 8
    for (int tt = 0; tt < 16; ++tt) { const int j = 16 * wave + tt; const bf16* vp = Z + (tok0 + j) * INW + ZC_GV;
        const v4u w1 = *(const v4u*)(vp + 8 * lane), w2 = *(const v4u*)(vp + 512 + 8 * lane);
        float x[16]; x[0] = bflo(w1.x); x[1] = bfhi(w1.x); x[2] = bflo(w1.y); x[3] = bfhi(w1.y); x[4] = bflo(w1.z); x[5] = bfhi(w1.z); x[6] = bflo(w1.w); x[7] = bfhi(w1.w);
        x[8] = bflo(w2.x); x[9] = bfhi(w2.x); x[10] = bflo(w2.y); x[11] = bfhi(w2.y); x[12] = bflo(w2.z); x[13] = bfhi(w2.z); x[14] = bflo(w2.w); x[15] = bfhi(w2.w);
        float s = 0.f;
#pragma unroll
        for (int e = 0; e < 16; ++e) s += x[e];
        const float mean = wave_sum(s) * (1.0f / 1024.0f); float q = 0.f;
#pragma unroll
        for (int e = 0; e < 16; ++e) { const float d = x[e] - mean; q += d * d; }
        const float rstd = 1.0f / sqrtf(wave_sum(q) * (1.0f / 1024.0f) + NORM_EPS);
        if (lane == 0) STAT[j] = (f32x2){mean, rstd}; }
#pragma unroll
    for (int i = 0; i < 8; ++i) { const int c = tid + 512 * i; const f32x4 v = wraw[i]; v2u w; w.x = pk2(v[0], v[1]); w.y = pk2(v[2], v[3]); *(LAS v2u*)(WS + (c >> 5) * PK + 4 * (c & 31)) = w; }
    __syncthreads();
    { const float* gn = inp(I_GMN) + l * 1024 + g * 256;
#pragma unroll
      for (int i = 0; i < 8; ++i) { const int c = tid + 512 * i; const int j = c >> 5, cc = c & 31; const v4u w1 = vraw[i];
            const f32x2 st = STAT[j]; const f32x4 n0 = *(const f32x4*)(gn + 8 * cc), n1 = *(const f32x4*)(gn + 8 * cc + 4);
            v4u o; o.x = pk2((bflo(w1.x) - st.x) * st.y * n0[0], (bfhi(w1.x) - st.x) * st.y * n0[1]); o.y = pk2((bflo(w1.y) - st.x) * st.y * n0[2], (bfhi(w1.y) - st.x) * st.y * n0[3]);
            o.z = pk2((bflo(w1.z) - st.x) * st.y * n1[0], (bfhi(w1.z) - st.x) * st.y * n1[1]); o.w = pk2((bflo(w1.w) - st.x) * st.y * n1[2], (bfhi(w1.w) - st.x) * st.y * n1[3]);
            *(LAS v4u*)(VN + j * PV + 8 * cc) = o; } }
    __syncthreads();
    f32x4 o[2][8];
#pragma unroll
    for (int mt = 0; mt < 2; ++mt)
#pragma unroll
        for (int nt = 0; nt < 8; ++nt) o[mt][nt] = (f32x4){0.f, 0.f, 0.f, 0.f};
#pragma unroll 1
    for (int ks = 0; ks < 4; ++ks) { bf16x8 av[2];
#pragma unroll
        for (int mt = 0; mt < 2; ++mt) av[mt] = frag_ck(VN, PV, 32 * ks, 32 * wave + 16 * mt, lane);
#pragma unroll
        for (int nt = 0; nt < 8; ++nt) { const bf16x8 bw = frag_rk(WS, PK, 16 * nt, 32 * ks, lane);
#pragma unroll
            for (int mt = 0; mt < 2; ++mt) o[mt][nt] = MFMA16(av[mt], bw, o[mt][nt]); } }
#pragma unroll
    for (int nt = 0; nt < 8; ++nt) { const int i = 16 * nt + li; const float bias = inp(I_GMBS)[(l * 4 + g) * 128 + i];
        const bf16* up = Z + (tok0 + i) * INW + ZC_GU + g * 256 + 32 * wave + g4; bf16* op = GMo + (tok0 + i) * 1024 + g * 256 + 32 * wave + g4;
#pragma unroll
        for (int mt = 0; mt < 2; ++mt) { const v2u uw = *(const v2u*)(up + 16 * mt); const f32x4 v = o[mt][nt] + bias;
            v2u w; w.x = pk2(v[0] * bflo(uw.x), v[1] * bfhi(uw.x)); w.y = pk2(v[2] * bflo(uw.y), v[3] * bfhi(uw.y)); *(v2u*)(op + 16 * mt) = w; } }
}

template <int NT, bool LOCAL>
__device__ __forceinline__ void attn_chunk(const LAS bf16* KT, const LAS bf16* VT, const bf16x8 (&qf)[4], f32x4 (&o)[8], float& m, float& lsum, const int lane,
                                           const int cs, const float* rpbh, const int roff0, const int qc) {
    const int g4 = 4 * (lane >> 4);
    f32x4 s[NT];
#pragma unroll
    for (int kt = 0; kt < NT; ++kt) { const int row0 = LOCAL ? 64 * (kt >> 1) + cs + 16 * (kt & 1) : 16 * kt; s[kt] = (f32x4){0.f, 0.f, 0.f, 0.f};
#pragma unroll
        for (int ks = 0; ks < 4; ++ks) s[kt] = MFMA16(frag_rk(KT, PK, row0, 32 * ks, lane), qf[ks], s[kt]);
        if (kt & 1) __builtin_amdgcn_sched_barrier(0); }
    const float sc2 = 0.08838834764831845f * LOG2E;
    float cmax = -1e30f;
#pragma unroll
    for (int kt = 0; kt < NT; ++kt)
#pragma unroll
        for (int r = 0; r < 4; ++r) { float v = s[kt][r] * sc2;
            if (LOCAL) { const int kc = cs + 16 * (kt & 1) + g4 + r; const int cst = min(max(qc - 8, 0), 48); const bool valid = (kc >= cst) && (kc < cst + 16);
                const float bias = rpbh[(roff0 + (kt >> 1)) * 31 + min(max(kc - qc + 15, 0), 30)]; v = valid ? v + bias * LOG2E : -1e30f; }
            s[kt][r] = v; cmax = fmaxf(cmax, v); }
    cmax = fmaxf(cmax, __shfl_xor(cmax, 16)); cmax = fmaxf(cmax, __shfl_xor(cmax, 32));
    const float mnew = fmaxf(m, cmax), alpha = __builtin_amdgcn_exp2f(m - mnew); m = mnew;
    float csum = 0.f;
#pragma unroll
    for (int kt = 0; kt < NT; ++kt)
#pragma unroll
        for (int r = 0; r < 4; ++r) { const float p = __builtin_amdgcn_exp2f(s[kt][r] - mnew); s[kt][r] = p; csum += p; }
    csum += __shfl_xor(csum, 16); csum += __shfl_xor(csum, 32);
    lsum = lsum * alpha + csum;
#pragma unroll
    for (int et = 0; et < 8; ++et) o[et] *= alpha;
#pragma unroll
    for (int pr = 0; pr < NT / 2; ++pr) {
        const int rowA = LOCAL ? 64 * pr + cs : 32 * pr, rowB = rowA + 16;
        v4u pw; pw.x = pk2(s[2 * pr][0], s[2 * pr][1]); pw.y = pk2(s[2 * pr][2], s[2 * pr][3]); pw.z = pk2(s[2 * pr + 1][0], s[2 * pr + 1][1]); pw.w = pk2(s[2 * pr + 1][2], s[2 * pr + 1][3]);
        const bf16x8 pb = __builtin_bit_cast(bf16x8, pw);
#pragma unroll
        for (int et = 0; et < 8; ++et) o[et] = MFMA16(frag_ck2(VT, PK, rowA, rowB, 16 * et, lane), pb, o[et]);
        __builtin_amdgcn_sched_barrier(0);
    }
}
template <int NPT> struct KVRaw { v4u k[NPT], v[NPT]; };
template <int NPT, int NTH> __device__ __forceinline__ void kv_load(KVRaw<NPT>& r, const bf16* ksrc, const bf16* vsrc, const size_t ld, const int t) {
#pragma unroll
    for (int i = 0; i < NPT; ++i) { const int c = t + NTH * i; const size_t off = (size_t)(c >> 4) * ld + 8 * (c & 15); r.k[i] = *(const v4u*)(ksrc + off); r.v[i] = *(const v4u*)(vsrc + off); }
}
template <int NPT, int NTH> __device__ __forceinline__ void kv_write(const KVRaw<NPT>& r, LAS bf16* KT, LAS bf16* VT, const int t) {
#pragma unroll
    for (int i = 0; i < NPT; ++i) { const int c = t + NTH * i; const int off = (c >> 4) * PK + 8 * (c & 15); *(LAS v4u*)(KT + off) = r.k[i]; *(LAS v4u*)(VT + off) = r.v[i]; }
}
__device__ __forceinline__ void attn_dense_unit(const Args& a, LAS unsigned char* lds, const int b, const int h, const int qb) {
    int tid = threadIdx.x; asm volatile("" : "+v"(tid)); const int lane = tid & 63, wave = __builtin_amdgcn_readfirstlane(tid >> 6);
    const bf16* Z = (const bf16*)(wsp(a) + WS_Z); bf16* NAo = (bf16*)(wsp(a) + WS_NA);
    LAS bf16* KT = (LAS bf16*)lds; LAS bf16* VT = KT + 128 * PK;
    const int g4 = 4 * (lane >> 4), li = lane & 15;
    const size_t qtok = (size_t)b * 256 + (size_t)qb * 128 + 16 * wave + li;
    const bf16* src = Z + ((size_t)b * 256) * INW + h * 128;
    KVRaw<4> kv; kv_load<4, 512>(kv, src + ZC_NK, src + ZC_NV, INW, tid);
    bf16x8 qf[4];
#pragma unroll
    for (int ks = 0; ks < 4; ++ks) qf[ks] = *(const bf16x8*)(Z + qtok * INW + ZC_NQ + h * 128 + 32 * ks + 2 * g4);
    f32x4 o[8];
#pragma unroll
    for (int et = 0; et < 8; ++et) o[et] = (f32x4){0.f, 0.f, 0.f, 0.f};
    float m = -1e30f, lsum = 0.f;
#pragma unroll 1
    for (int ch = 0; ch < 2; ++ch) {
        __syncthreads();
        kv_write<4, 512>(kv, KT, VT, tid);
        __syncthreads();
        if (ch == 0) kv_load<4, 512>(kv, src + (size_t)128 * INW + ZC_NK, src + (size_t)128 * INW + ZC_NV, INW, tid);
        attn_chunk<8, false>(KT, VT, qf, o, m, lsum, lane, 0, nullptr, 0, 0);
    }
    const float inv = 1.0f / lsum;
    bf16* op = NAo + qtok * 1024 + h * 128 + g4;
#pragma unroll
    for (int et = 0; et < 8; ++et) { v2u w; w.x = pk2(o[et][0] * inv, o[et][1] * inv); w.y = pk2(o[et][2] * inv, o[et][3] * inv); *(v2u*)(op + 16 * et) = w; }
}
__device__ __forceinline__ void attn_na_unit(const Args& a, const int l, LAS unsigned char* lds, const int b, const int r, const int hp) {
    int tid = threadIdx.x; asm volatile("" : "+v"(tid)); const int lane = tid & 63, wave = __builtin_amdgcn_readfirstlane(tid >> 6);
    const bf16* Z = (const bf16*)(wsp(a) + WS_Z); bf16* NAo = (bf16*)(wsp(a) + WS_NA);
    const int hg = wave >> 2, h = 2 * hp + hg, qa = wave & 3, gt = tid & 255;
    LAS bf16* KT = (LAS bf16*)lds + hg * (2 * 128 * PK); LAS bf16* VT = KT + 128 * PK;
    const int g4 = 4 * (lane >> 4), li = lane & 15;
    const int qc = 16 * qa + li;
    const size_t qtok = (size_t)MC + (size_t)b * 1024 + (size_t)r * 64 + qc;
    const int cs = qa == 0 ? 0 : (qa == 1 ? 8 : (qa == 2 ? 24 : 32));
    const int rs = min(max(r - 4, 0), 8);
    const float* rpbh = inp(I_RPB) + (size_t)(l * 8 + h) * 15 * 31;
    const bf16* lsrc = Z + ((size_t)MC + (size_t)b * 1024 + (size_t)rs * 64) * INW + h * 128;
    const bf16* cksrc = (const bf16*)(wsp(a) + WS_CKB) + ((size_t)((b * 2 + l) * 256)) * 1024 + h * 128;
    const bf16* cvsrc = (const bf16*)(wsp(a) + WS_CVB) + ((size_t)((b * 2 + l) * 256)) * 1024 + h * 128;
    KVRaw<8> kv; kv_load<8, 256>(kv, lsrc + ZC_NK, lsrc + ZC_NV, INW, gt);
    bf16x8 qf[4];
#pragma unroll
    for (int ks = 0; ks < 4; ++ks) qf[ks] = *(const bf16x8*)(Z + qtok * INW + ZC_NQ + h * 128 + 32 * ks + 2 * g4);
    f32x4 o[8];
#pragma unroll
    for (int et = 0; et < 8; ++et) o[et] = (f32x4){0.f, 0.f, 0.f, 0.f};
    float m = -1e30f, lsum = 0.f;
#pragma unroll 1
    for (int ch = 0; ch < 4; ++ch) {
        __syncthreads();
        kv_write<8, 256>(kv, KT, VT, gt);
        __syncthreads();
        if (ch < 3) { const bf16* s2 = lsrc + (size_t)(128 * (ch + 1)) * INW; kv_load<8, 256>(kv, s2 + ZC_NK, s2 + ZC_NV, INW, gt); }
        else kv_load<8, 256>(kv, cksrc, cvsrc, 1024, gt);
        attn_chunk<4, true>(KT, VT, qf, o, m, lsum, lane, cs, rpbh, rs + 2 * ch - r + 7, qc);
    }
#pragma unroll 1
    for (int ch = 0; ch < 2; ++ch) {
        __syncthreads();
        kv_write<8, 256>(kv, KT, VT, gt);
        __syncthreads();
        if (ch == 0) kv_load<8, 256>(kv, cksrc + (size_t)128 * 1024, cvsrc + (size_t)128 * 1024, 1024, gt);
        attn_chunk<8, false>(KT, VT, qf, o, m, lsum, lane, 0, nullptr, 0, 0);
    }
    const float inv = 1.0f / lsum;
    bf16* op = NAo + qtok * 1024 + h * 128 + g4;
#pragma unroll
    for (int et = 0; et < 8; ++et) { v2u w; w.x = pk2(o[et][0] * inv, o[et][1] * inv); w.y = pk2(o[et][2] * inv, o[et][3] * inv); *(v2u*)(op + 16 * et) = w; }
}
#ifndef REP_GEMM
#define REP_GEMM 1
#endif
#ifndef REP_THIN
#define REP_THIN 1
#endif
#ifndef REP_CONV
#define REP_CONV 1
#endif
#ifndef REP_MIX1
#define REP_MIX1 1
#endif
#ifndef REP_MIX2
#define REP_MIX2 1
#endif
#ifndef REP_UP
#define REP_UP REP_GEMM
#endif
#ifndef REP_DN
#define REP_DN REP_GEMM
#endif
#ifndef REP_IN
#define REP_IN REP_GEMM
#endif
#ifndef REP_BR
#define REP_BR REP_GEMM
#endif
#ifndef REP_OUT
#define REP_OUT REP_GEMM
#endif
#ifndef REP_BAR
#define REP_BAR 1
#endif
#ifndef REP_R1
#define REP_R1 1
#endif
#ifndef REP_GM
#define REP_GM 1
#endif
#ifndef REP_AD
#define REP_AD 1
#endif
#ifndef REP_AN
#define REP_AN 1
#endif
#define REPEAT(n) _Pragma("clang loop unroll(full)") for (int rep_ = 0; rep_ < (n); ++rep_)
#ifndef NLAYER_LOOP
#define NLAYER_LOOP 2
#endif
#ifndef NSUB_LOOP
#define NSUB_LOOP 2
#endif
#ifndef EN_CONV
#define EN_CONV 1
#endif
#ifndef EN_THIN
#define EN_THIN 1
#endif
#ifndef EN_GEMM
#define EN_GEMM 1
#endif
#ifndef EN_R1
#define EN_R1 1
#endif
#ifndef EN_GM
#define EN_GM 1
#endif
#ifndef EN_AD
#define EN_AD 1
#endif
#ifndef EN_AN
#define EN_AN 1
#endif
#ifndef EN_R2
#define EN_R2 1
#endif

#ifndef MK_SPLIT
#define MK_SPLIT 0
#endif
constexpr int NPH = 14;
enum { PH_CONV = 0, PH_INIT, PH_UP0, PH_DN0, PH_THA, PH_IN, PH_MIX1, PH_MIX2, PH_BR, PH_OUT, PH_THB, PH_UP1, PH_DN1, PH_THC };

__global__ void __launch_bounds__(NWAVES * 64, 2) fwd_kernel(Args args) {
    extern __shared__ __attribute__((aligned(16))) unsigned char lds_raw[];
    LAS unsigned char* lds = (LAS unsigned char*)lds_raw;
    volatile LAS unsigned* MISC = (volatile LAS unsigned*)(lds + MISC_OFF);
    const int tid = threadIdx.x;
    const int G = gridDim.x; const int vcu = blockIdx.x;
    for (int u = tid; u < (LDS_BYTES - MISC_OFF) / 4; u += NWAVES * 64) ((LAS unsigned*)(lds + MISC_OFF))[u] = 0u;
    __syncthreads();
    unsigned* barw = (unsigned*)(wsp(args) + WS_CTL) + CW_BAR;
    XcdBarrier bar = xcd_barrier_post(barw, MISC + 8);
    const int lo = args.ph_lo, hi = args.ph_hi;
#define IN(k) (lo <= (k) && (k) < hi)
#define SEAM(k) do { if ((k) + 1 < hi) { for (int rb_ = 0; rb_ < REP_BAR; ++rb_) xcd_barrier(bar); } } while (0)
#pragma clang loop unroll(full)
    for (int l = 0; l < NLAYER_LOOP; ++l) {
        const int pb = l * NPH;
        if (EN_CONV && l == 0 && IN(pb + PH_CONV)) { REPEAT(REP_CONV) conv_phase(args, l, lds, vcu, G); SEAM(pb + PH_CONV); }
        if (l == 0 && IN(pb + PH_INIT)) { if (EN_THIN) REPEAT(REP_THIN) thin_phase<true, false, true>(args, 0, 0, 0.f, 0, 0, vcu, G); SEAM(pb + PH_INIT); }
#pragma clang loop unroll(full)
        for (int s = 0; s < NSUB_LOOP; ++s) {
            if (IN(pb + (s ? PH_UP1 : PH_UP0))) {
                unsigned char* ws = wsp(args);
                pg8::Gemm g{(const pg8::bf16_t*)(ws + WS_H), (const pg8::bf16_t*)(ws + WS_WT + WT_UP + (size_t)s * 44 * MiB), M, FF2, D}; pg8::StaticOrder S; S.init(M, FF2, G, vcu);
                pg8::EpiSwiglu E{(pg8::bf16_t*)(ws + WS_Z), FF};
                if (EN_GEMM) REPEAT(REP_UP) pg8::gemm_phase<pg8::EpiSwiglu, pg8::StaticOrder, true, true>(lds, g, S, E);
                SEAM(pb + (s ? PH_UP1 : PH_UP0));
            }
            if (IN(pb + (s ? PH_DN1 : PH_DN0))) {
                unsigned char* ws = wsp(args);
                pg8::Gemm g{(const pg8::bf16_t*)(ws + WS_Z), (const pg8::bf16_t*)(ws + WS_WT + WT_DN + (size_t)s * 22 * MiB), M, D, FF}; pg8::StaticOrder S; S.init(M, D, G, vcu);
                pg8::EpiBf16 E{(pg8::bf16_t*)(ws + WS_Y), D};
                if (EN_GEMM) REPEAT(REP_DN) pg8::gemm_phase<pg8::EpiBf16, pg8::StaticOrder, true, true>(lds, g, S, E);
                SEAM(pb + (s ? PH_DN1 : PH_DN0));
            }
            if (s == 0) {
                if (IN(pb + PH_THA)) { if (EN_THIN) REPEAT(REP_THIN) thin_phase<false, true, true>(args, l, 0, rep_ == REP_THIN - 1 ? 0.5f : 0.f, l, 1, vcu, G); SEAM(pb + PH_THA); }
                if (IN(pb + PH_IN)) {
                    unsigned char* ws = wsp(args); float* outb = outp(args);
                    pg8::Gemm g{(const pg8::bf16_t*)(ws + WS_H), (const pg8::bf16_t*)(ws + WS_WT + WT_IN), M, INW, D}; pg8::StaticOrder S; S.init(M, INW, G, vcu);
                    pg8::EpiZ E{(pg8::bf16_t*)(ws + WS_Z), INW, outb + OUT_CK + (size_t)l * 256 * 1024, outb + OUT_CV + (size_t)l * 256 * 1024};
                    if (EN_GEMM) REPEAT(REP_IN) pg8::gemm_phase<pg8::EpiZ, pg8::StaticOrder, true, true>(lds, g, S, E);
                    SEAM(pb + PH_IN);
                }
                if (IN(pb + PH_MIX1)) { REPEAT(REP_MIX1) {
                    REPEAT(REP_R1) for (int sl = vcu; sl < 256; sl += G) {
                        const int nch = sl < 128 ? 1 : 4;
                        for (int k = 0; k < nch; ++k) { const int c = sl < 128 ? sl : (sl - 128) * 4 + k; if (EN_R1) ret_chain(args, l, lds, sl < 128 ? 1 : 0, c >> 4, (c >> 1) & 7, c & 1); }
                    }
                    REPEAT(REP_GM) for (int u = vcu; u < 512; u += G) { const int grp = u >> 8, v = u & 255; if (EN_GM) gmlp_unit(args, l, lds, grp, grp ? v >> 5 : v >> 3, grp ? (v >> 2) & 7 : (v >> 2) & 1, v & 3); }
                    REPEAT(REP_AD) for (int u = vcu; u < 512; u += G) if (EN_AD) attn_dense_unit(args, lds, u >> 4, (u >> 1) & 7, u & 1);
                    REPEAT(REP_AN) for (int u = vcu; u < 512; u += G) if (EN_AN) attn_na_unit(args, l, lds, u >> 6, (u >> 2) & 15, u & 3);
                    }
                    SEAM(pb + PH_MIX1);
                }
                if (IN(pb + PH_MIX2)) { if (EN_R2) ret_out_rot(args, lds); REPEAT(REP_MIX2) {
                    for (int u = vcu; u < 1024; u += G) { const int grp = u >> 9, v = u & 511; if (EN_R2) ret_out_unit(args, l, lds, grp, grp ? v >> 6 : v >> 4, grp ? (v >> 3) & 7 : (v >> 1) & 7, grp ? v & 7 : v & 1); }
                    }
                    SEAM(pb + PH_MIX2);
                }
                if (IN(pb + PH_BR)) {
                    unsigned char* ws = wsp(args);
                    pg8::StaticOrder S; S.init(M, D, G, vcu);
                    const pg8::bf16_t* Zb = (const pg8::bf16_t*)(ws + WS_Z);
                    if (EN_GEMM) REPEAT(REP_BR) {
                    { pg8::Gemm g{(const pg8::bf16_t*)(ws + WS_RET), (const pg8::bf16_t*)(ws + WS_WT + WT_BR), M, D, D};
                      pg8::EpiMerge<0> E{Zb + ZC_GA, INW, (pg8::bf16_t*)(ws + WS_H), D}; pg8::gemm_phase<pg8::EpiMerge<0>, pg8::StaticOrder, true, true>(lds, g, S, E); }
                    { pg8::Gemm g{(const pg8::bf16_t*)(ws + WS_GM), (const pg8::bf16_t*)(ws + WS_WT + WT_BG), M, D, 1024};
                      pg8::EpiMerge<1> E{Zb + ZC_GA + 2048, INW, (pg8::bf16_t*)(ws + WS_H), D}; pg8::gemm_phase<pg8::EpiMerge<1>, pg8::StaticOrder, true, true>(lds, g, S, E); }
                    { pg8::Gemm g{(const pg8::bf16_t*)(ws + WS_NA), (const pg8::bf16_t*)(ws + WS_WT + WT_BN), M, D, 1024};
                      pg8::EpiMerge<2> E{Zb + ZC_GA + 4096, INW, (pg8::bf16_t*)(ws + WS_H), D}; pg8::gemm_phase<pg8::EpiMerge<2>, pg8::StaticOrder, true, true>(lds, g, S, E); }
                    }
                    SEAM(pb + PH_BR);
                }
                if (IN(pb + PH_OUT)) {
                    unsigned char* ws = wsp(args);
                    pg8::Gemm g{(const pg8::bf16_t*)(ws + WS_H), (const pg8::bf16_t*)(ws + WS_WT + WT_OUT), M, D, D}; pg8::StaticOrder S; S.init(M, D, G, vcu);
                    pg8::EpiBf16 E{(pg8::bf16_t*)(ws + WS_Y), D};
                    if (EN_GEMM) REPEAT(REP_OUT) pg8::gemm_phase<pg8::EpiBf16, pg8::StaticOrder, true, true>(lds, g, S, E);
                    SEAM(pb + PH_OUT);
                }
                if (IN(pb + PH_THB)) { if (EN_THIN) REPEAT(REP_THIN) thin_phase<false, true, true>(args, l, 1, rep_ == REP_THIN - 1 ? 1.0f : 0.f, l, 2, vcu, G); SEAM(pb + PH_THB); }
            } else {
                if (IN(pb + PH_THC)) {
                    if (l == 0) { if (EN_THIN) REPEAT(REP_THIN) thin_phase<false, true, true>(args, 0, 2, rep_ == REP_THIN - 1 ? 0.5f : 0.f, 1, 0, vcu, G); if (EN_CONV) REPEAT(REP_CONV) conv_phase(args, 1, lds, vcu, G); }
                    else        { if (EN_THIN) REPEAT(REP_THIN) thin_phase<false, true, false>(args, 1, 2, rep_ == REP_THIN - 1 ? 0.5f : 0.f, 0, 0, vcu, G); }
                    SEAM(pb + PH_THC);
                }
            }
        }
    }
#undef IN
#undef SEAM
}

extern "C" void kernel_launch(void* const* d_in, const int* in_sizes, int n_in, void* d_out, int out_size, void* d_ws, size_t ws_size, hipStream_t stream) {
    static int grid = 0;
    if (grid == 0) {
        if (n_in != N_IN || (size_t)out_size != OUT_TOTAL || ws_size < WS_END) { fprintf(stderr, "kernel_launch: unexpected shapes: n_in %d out %d ws %zu (need %zu); nothing launched\n", n_in, out_size, ws_size, (size_t)WS_END); grid = -1; return; }
        int dev = 0, cus = 0, per_cu = 0;
        if (hipGetDevice(&dev) != hipSuccess || hipDeviceGetAttribute(&cus, hipDeviceAttributeMultiprocessorCount, dev) != hipSuccess) { grid = -1; return; }
        if (hipFuncSetAttribute((const void*)fwd_kernel, hipFuncAttributeMaxDynamicSharedMemorySize, LDS_BYTES) != hipSuccess) { fprintf(stderr, "kernel_launch: hipFuncSetAttribute failed\n"); grid = -1; return; }
        if (hipOccupancyMaxActiveBlocksPerMultiprocessor(&per_cu, (const void*)fwd_kernel, NWAVES * 64, LDS_BYTES) != hipSuccess || per_cu < 1) { fprintf(stderr, "kernel_launch: occupancy query reports %d workgroups per CU\n", per_cu); }
        (void)hipGetLastError();
        grid = cus;
        if (per_cu < 1) grid = -1;
    }
    if (grid < 0) return;
    if (hipMemsetAsync((char*)d_ws + WS_CTL, 0, CTL_ZERO_BYTES, stream) != hipSuccess) return;
    Args a{};
    for (int i = 0; i < N_IN; ++i) a.in[i] = (const float*)d_in[i];
    a.out = (float*)d_out; a.ws = (unsigned char*)d_ws;
#if MK_SPLIT
    for (int p = 0; p < 2 * NPH; ++p) { if (p == NPH + PH_INIT || p == NPH + PH_CONV) continue; a.ph_lo = p; a.ph_hi = p + 1; hipLaunchKernelGGL(fwd_kernel, dim3(grid), dim3(NWAVES * 64), LDS_BYTES, stream, a); }
#else
    a.ph_lo = 0; a.ph_hi = 2 * NPH;
    hipLaunchKernelGGL(fwd_kernel, dim3(grid), dim3(NWAVES * 64), LDS_BYTES, stream, a);
#endif
    const hipError_t le = hipPeekAtLastError();
    if (le != hipSuccess) fprintf(stderr, "kernel_launch: launch failed: %s\n", hipGetErrorName(le));
}
```
